# Optimizing an MI355X kernel written in HIP

```python
import jax
import jax.numpy as jnp
from jax import lax
import numpy as np

D_MODEL = 1024
BATCH = 4
SEQ = 8192
DEPTH = 2

A_HEADS = 4
A_KDIM = 128
A_VDIM = 128
A_CHUNK = 64
B_GROUPS = 4
B_GDIM = 128
B_CHUNK = 128
C_QHEADS = 8
C_KVHEADS = 2
C_HDIM = 64
C_WINDOW = 128
C_BLOCK = 128
ROPE_THETA = 500000.0
ROPE_DIM = C_HDIM // 4
N_BRANCH = 3
D_FF = 4 * D_MODEL
EPS = 1e-6

A_KW = A_HEADS * A_KDIM
A_VW = A_HEADS * A_VDIM
B_W = B_GROUPS * B_GDIM
C_QW = C_QHEADS * C_HDIM
C_KVW = C_KVHEADS * C_HDIM
BRANCH_W = A_VW
SPLIT_SIZES = (A_KW, A_VW, A_KW, A_KW, A_VW, B_W, B_W, C_QW, C_KVW, C_KVW, N_BRANCH * D_MODEL)
D_IN = sum(SPLIT_SIZES)

kernel_name = 'hybrid_hgrn2_gmlp_swa_encoder'


def rms_norm(x, w):
    xf = x.astype(jnp.float32)
    y = xf * lax.rsqrt(jnp.mean(xf * xf, axis=-1, keepdims=True) + EPS)
    return (y * w.astype(jnp.float32)).astype(x.dtype)


def layer_norm(x):
    xf = x.astype(jnp.float32)
    xc = xf - jnp.mean(xf, axis=-1, keepdims=True)
    return (xc * lax.rsqrt(jnp.mean(xc * xc, axis=-1, keepdims=True) + EPS)).astype(x.dtype)


def partial_rope(t, pos):
    half = ROPE_DIM // 2
    inv = ROPE_THETA ** (-jnp.arange(half, dtype=jnp.float32) * (2.0 / ROPE_DIM))
    ang = pos[:, None] * inv[None, :]
    cos = jnp.cos(ang)[None, :, None, :]
    sin = jnp.sin(ang)[None, :, None, :]
    tf = t[..., :ROPE_DIM].astype(jnp.float32)
    t1, t2 = tf[..., :half], tf[..., half:]
    rot = jnp.concatenate([t1 * cos - t2 * sin, t2 * cos + t1 * sin], axis=-1)
    return jnp.concatenate([rot.astype(t.dtype), t[..., ROPE_DIM:]], axis=-1)


def window_attention(q, k, v, sink):
    bsz, s_len = q.shape[0], q.shape[1]
    nb = s_len // C_BLOCK
    grp = C_QHEADS // C_KVHEADS
    qb = q.reshape(bsz, nb, C_BLOCK, C_KVHEADS, grp, C_HDIM)
    pad = ((0, 0), (C_BLOCK, C_BLOCK), (0, 0), (0, 0))

    def band(t):
        tp = jnp.pad(t, pad).reshape(bsz, nb + 2, C_BLOCK, C_KVHEADS, C_HDIM)
        return jnp.concatenate([tp[:, :-2], tp[:, 1:-1], tp[:, 2:]], axis=2)

    kb, vb = band(k), band(v)
    scores = jnp.einsum('bnqhgd,bnkhd->bnhgqk', qb, kb).astype(jnp.float32) * (C_HDIM ** -0.5)
    blk = jnp.arange(nb)[:, None, None]
    qpos = blk * C_BLOCK + jnp.arange(C_BLOCK)[None, :, None]
    kpos = (blk - 1) * C_BLOCK + jnp.arange(3 * C_BLOCK)[None, None, :]
    mask = (jnp.abs(qpos - kpos) <= C_WINDOW) & (kpos >= 0) & (kpos < s_len)
    scores = jnp.where(mask[None, :, None, None], scores, -jnp.inf)
    sink_l = sink.astype(jnp.float32).reshape(C_KVHEADS, grp)[None, None, :, :, None, None]
    m = jnp.maximum(jnp.max(scores, axis=-1, keepdims=True), sink_l)
    p = jnp.exp(scores - m)
    p = p / (jnp.sum(p, axis=-1, keepdims=True) + jnp.exp(sink_l - m))
    o = jnp.einsum('bnhgqk,bnkhd->bnqhgd', p.astype(v.dtype), vb)
    return o.reshape(bsz, s_len, C_QW)


def hgrn2_gate(z, lb):
    zf = z.astype(jnp.float32)
    log_f = jnp.logaddexp(jnp.log(lb), jnp.log1p(-lb) + jax.nn.log_sigmoid(zf))
    key = (1.0 - lb) * jax.nn.sigmoid(-zf)
    return log_f, key


def gated_linear_scan(q, k, v, log_f):
    n, s_len = q.shape[0], q.shape[1]
    nc = s_len // A_CHUNK

    def to_chunks(t):
        return t.reshape(n, nc, A_CHUNK, A_HEADS, t.shape[-1]).transpose(1, 0, 3, 2, 4)

    qc, kc, vc = to_chunks(q), to_chunks(k), to_chunks(v)
    bc = jnp.cumsum(to_chunks(log_f), axis=3)
    tri = jnp.tril(jnp.ones((A_CHUNK, A_CHUNK), dtype=bool))

    def step(state, inp):
        qt, kt, vt, bt = inp
        b_last = bt[:, :, -1:, :]
        o_inter = jnp.einsum('nhck,nhkv->nhcv', qt * jnp.exp(bt), state)
        diff = bt[:, :, :, None, :] - bt[:, :, None, :, :]
        decay = jnp.exp(jnp.where(tri[:, :, None], diff, -jnp.inf))
        attn = jnp.einsum('nhtk,nhsk,nhtsk->nhts', qt, kt, decay)
        o_intra = jnp.einsum('nhts,nhsv->nhtv', attn, vt)
        state = jnp.exp(b_last[:, :, 0, :])[..., None] * state + jnp.einsum(
            'nhsk,nhsv->nhkv', kt * jnp.exp(b_last - bt), vt)
        return state, o_inter + o_intra

    state0 = jnp.zeros((n, A_HEADS, A_KDIM, A_VDIM), jnp.float32)
    _, o = lax.scan(step, state0, (qc, kc, vc, bc))
    return o.transpose(1, 0, 3, 2, 4).reshape(n, s_len, A_HEADS, A_VDIM)


def hgrn2_bidirectional(q, i, zf_fwd, zf_bwd, lb):
    bsz, s_len = q.shape[0], q.shape[1]
    shp = (bsz, s_len, A_HEADS, A_KDIM)
    qf = q.astype(jnp.float32).reshape(shp)
    vf = i.astype(jnp.float32).reshape(bsz, s_len, A_HEADS, A_VDIM)
    lf_f, k_f = hgrn2_gate(zf_fwd.reshape(shp), lb[0])
    lf_b, k_b = hgrn2_gate(zf_bwd.reshape(shp), lb[1])

    def flip(t):
        return t[:, ::-1]

    o = gated_linear_scan(
        jnp.concatenate([qf, flip(qf)], axis=0),
        jnp.concatenate([k_f, flip(k_b)], axis=0),
        jnp.concatenate([vf, flip(vf)], axis=0),
        jnp.concatenate([lf_f, flip(lf_b)], axis=0))
    return o[:bsz] + flip(o[bsz:])


def spatial_gating(u, v, w_s, b_s):
    bsz, s_len = u.shape[0], u.shape[1]
    nb = s_len // B_CHUNK
    vn = layer_norm(v).reshape(bsz, nb, B_CHUNK, B_GROUPS, B_GDIM)
    mixed = jnp.einsum('bnpgc,gqp->bnqgc', vn, w_s) + b_s.T[None, None, :, :, None]
    return u * mixed.reshape(bsz, s_len, B_W)


def setup_inputs(seed: int = 0) -> dict:
    key = jax.random.key(seed)
    ks = jax.random.split(key, 14)
    f32 = jnp.float32

    def nrm(k, shape, scale):
        return jax.random.normal(k, shape, f32) * scale

    return {
        'x': nrm(ks[0], (BATCH, SEQ, D_MODEL), 1.0),
        'w_in': nrm(ks[1], (DEPTH, D_MODEL, D_IN), D_MODEL ** -0.5),
        'ln1': 1.0 + nrm(ks[2], (DEPTH, D_MODEL), 0.02),
        'lb_logits': nrm(ks[3], (DEPTH, 2, A_KW), 0.5),
        'a_norm': 1.0 + nrm(ks[4], (DEPTH, A_VDIM), 0.02),
        'w_s': nrm(ks[5], (DEPTH, B_GROUPS, B_CHUNK, B_CHUNK), B_CHUNK ** -0.5),
        'b_s': 1.0 + nrm(ks[6], (DEPTH, B_GROUPS, B_CHUNK), 0.1),
        'sink': nrm(ks[7], (DEPTH, C_QHEADS), 0.5),
        'w_br': nrm(ks[8], (DEPTH, N_BRANCH, BRANCH_W, D_MODEL), BRANCH_W ** -0.5),
        'w_out': nrm(ks[9], (DEPTH, D_MODEL, D_MODEL), D_MODEL ** -0.5),
        'ln2': 1.0 + nrm(ks[10], (DEPTH, D_MODEL), 0.02),
        'w_up': nrm(ks[11], (DEPTH, D_MODEL, D_FF), D_MODEL ** -0.5),
        'w_down': nrm(ks[12], (DEPTH, D_FF, D_MODEL), D_FF ** -0.5),
        'final_norm': 1.0 + nrm(ks[13], (D_MODEL,), 0.02),
    }


def reference(x, w_in, ln1, lb_logits, a_norm, w_s, b_s, sink, w_br, w_out, ln2, w_up, w_down, final_norm):
    bsz, s_len = x.shape[0], x.shape[1]
    pos = jnp.arange(s_len, dtype=jnp.float32)
    p = jax.nn.softmax(lb_logits.astype(jnp.float32), axis=0)
    cum = jnp.cumsum(p, axis=0)
    lower = (cum - cum[0:1]).reshape(DEPTH, 2, A_HEADS, A_KDIM)
    offsets = np.cumsum(SPLIT_SIZES)[:-1].tolist()
    for l in range(DEPTH):
        xn = rms_norm(x, ln1[l])
        z = xn @ w_in[l]
        a_q, a_i, a_ff, a_fb, a_g, b_u, b_v, c_q, c_k, c_v, gz = jnp.split(z, offsets, axis=-1)
        o_a = hgrn2_bidirectional(a_q, a_i, a_ff, a_fb, lower[l])
        y_a = (rms_norm(o_a, a_norm[l]) * jax.nn.silu(a_g.astype(jnp.float32).reshape(o_a.shape)))
        y_a = y_a.astype(x.dtype).reshape(bsz, s_len, A_VW)
        y_b = spatial_gating(jax.nn.gelu(b_u), jax.nn.gelu(b_v), w_s[l], b_s[l])
        qh = partial_rope(c_q.reshape(bsz, s_len, C_QHEADS, C_HDIM), pos)
        kh = partial_rope(c_k.reshape(bsz, s_len, C_KVHEADS, C_HDIM), pos)
        vh = c_v.reshape(bsz, s_len, C_KVHEADS, C_HDIM)
        y_c = window_attention(qh, kh, vh, sink[l])
        gates = jax.nn.sigmoid(gz.reshape(bsz, s_len, N_BRANCH, D_MODEL))
        merged = (gates[:, :, 0] * (y_a @ w_br[l, 0])
                  + gates[:, :, 1] * (y_b @ w_br[l, 1])
                  + gates[:, :, 2] * (y_c @ w_br[l, 2]))
        x = x + merged @ w_out[l]
        hn = rms_norm(x, ln2[l])
        x = x + jnp.square(jax.nn.relu(hn @ w_up[l])) @ w_down[l]
    return rms_norm(x, final_norm)
```

```cpp
#include <hip/hip_runtime.h>
#include <hip/hip_cooperative_groups.h>
#include <cstdio>
#include <cstdint>
namespace cg = cooperative_groups;

#ifndef PH_MASK
#define PH_MASK 0x7ff
#endif
#ifndef BR_MASK
#define BR_MASK 7
#endif
#ifndef A_MASK
#define A_MASK 3
#endif
#ifndef TPROBE_A
#define TPROBE_A -1
#endif
#ifndef TPROBE_B
#define TPROBE_B -1
#endif
#ifndef DUP_GEMM
#define DUP_GEMM 0
#endif
#ifndef DUP_SYNC
#define DUP_SYNC 0
#endif
#ifndef DUP_THIN
#define DUP_THIN 0
#endif
#ifndef USE_XB
#define USE_XB 1
#endif
#ifndef DUP_P1
#define DUP_P1 0
#endif
#ifndef DUP_P3
#define DUP_P3 0
#endif
#ifndef DUP_C
#define DUP_C 0
#endif
#define PHON(n) ((PH_MASK >> (n)) & 1)
#ifndef MK_ONE_LAUNCH
#define MK_ONE_LAUNCH 1
#endif

#define LAS __attribute__((address_space(3)))
typedef unsigned short bf16_t;
typedef short bf16x8 __attribute__((ext_vector_type(8)));
typedef float f32x4 __attribute__((ext_vector_type(4)));
typedef float f32x2 __attribute__((ext_vector_type(2)));
typedef unsigned u32x4 __attribute__((ext_vector_type(4)));
typedef unsigned u32x2 __attribute__((ext_vector_type(2)));

constexpr int T = 32768, SEQ = 8192, D = 1024, DFF = 4096, DIN = 7424, NZ = 4352, LDZ = 5376, DEPTH = 2;
constexpr int ZQ = 0, ZI = 512, ZFF = 1024, ZFB = 1536, ZG = 2048, ZU = 2560, ZV = 3072, ZCQ = 3584, ZCK = 4096, ZCV = 4224, ZXN = 4352;
constexpr float EPS = 1e-6f;
constexpr size_t MiB = 1u << 20;
constexpr size_t WS_ROPE = 0;
constexpr size_t WS_WSB = 1 * MiB;
constexpr size_t WS_LOW = 640 * 1024;
constexpr size_t WS_ETN = 1 * MiB + 256 * 1024;
constexpr size_t WS_SUMSQ = 1 * MiB + 512 * 1024;
constexpr size_t WS_DEC = 2 * MiB;
constexpr size_t WS_W = 4 * MiB;
constexpr size_t W_IN = 0, W_BR = (size_t)DIN * D * 2, W_OUT = W_BR + (size_t)3 * D * 512 * 2, W_UP = W_OUT + (size_t)D * D * 2, W_DN = W_UP + (size_t)DFF * D * 2;
constexpr size_t WS_Z = 40 * MiB;
constexpr size_t WS_L = 376 * MiB;
constexpr size_t WS_MERGED = WS_L, WS_SST = WS_L + 64 * MiB, WS_HN = WS_L;
constexpr size_t WS_ENR = 504 * MiB;
constexpr size_t WS_END = 506 * MiB;
constexpr int LDS_BYTES = 147456;
constexpr int NPH = 9 * DEPTH + 1;

typedef __bf16 bf16v2_t __attribute__((ext_vector_type(2)));
__device__ __forceinline__ unsigned cvt_pk_bf16(float lo, float hi) { const f32x2 v = {lo, hi}; const bf16v2_t b = __builtin_convertvector(v, bf16v2_t); return __builtin_bit_cast(unsigned, b); }
__device__ __forceinline__ float bf_lo(unsigned w) { return __uint_as_float(w << 16); }
__device__ __forceinline__ float bf_hi(unsigned w) { return __uint_as_float(w & 0xffff0000u); }
__device__ __forceinline__ float bf2f(bf16_t b) { return __uint_as_float(((unsigned)b) << 16); }
__device__ __forceinline__ bf16_t f2bf(float f) { return (bf16_t)(cvt_pk_bf16(f, 0.f) & 0xffffu); }
__device__ __forceinline__ float wave_sum(float v) {
#pragma unroll
    for (int o = 1; o < 64; o <<= 1) v += __shfl_xor(v, o);
    return v;
}
__device__ __forceinline__ float gelu_tanh(float x) { const float u = 1.5957691216f * (x + 0.044715f * x * x * x); return x * __builtin_amdgcn_rcpf(1.0f + __expf(-u)); }
__device__ __forceinline__ float sigmoidf_(float x) { return __builtin_amdgcn_rcpf(1.0f + __expf(-x)); }

namespace pg8 {
constexpr int BM = 256, BK = 64, HALF = 128, HTB = HALF * BK * 2, STAGE_BYTES = 8 * HTB, NXCD = 8, WGM = 8;
__host__ __device__ __forceinline__ int lds_byte(int r, int c) { const int st = (r >> 4) * 2 + (c >> 5), rr = r & 15, cc = c & 31, ob = rr * 64 + cc * 2; return st * 1024 + (ob ^ (((ob >> 9) & 1) << 5)); }
__host__ __device__ __forceinline__ void stage_rc(int b, int& R, int& C) { const int st = b / 1024, sb = b % 1024, swz = sb ^ (((sb >> 9) & 1) << 5); R = (st >> 1) * 16 + swz / 64; C = (st & 1) * 32 + (swz % 64) / 2; }
__host__ __device__ __forceinline__ int perm32(int rho) { const int n = rho >> 4, i = rho & 15; return 8 * (i >> 2) + 4 * n + (i & 3); }

struct Unit { int pm, pn; };
struct Gemm { const bf16_t* A; const bf16_t* Bt; int M, N, K, lda; };

struct StaticOrder {
    int nM, nN, nwg, G, c;
    __device__ void init(int M, int N, int G_, int c_) { nM = M / BM; nN = N / BM; nwg = nM * nN; G = G_; c = c_; }
    __device__ bool next(int i, Unit& u) const {
        const long L = (long)i * G + c; if (L >= nwg) return false;
        int wgid = (int)L; { const int q = nwg / NXCD, r = nwg % NXCD, xcd = wgid % NXCD, off = wgid / NXCD; wgid = (xcd < r ? xcd * (q + 1) : r * (q + 1) + (xcd - r) * q) + off; }
        const int nig = WGM * nN, gid = wgid / nig, fm = gid * WGM, gsz = (nM - fm) < WGM ? (nM - fm) : WGM;
        u.pm = fm + ((wgid % nig) % gsz); u.pn = (wgid % nig) / gsz; return true;
    }
};

typedef const f32x4 (&AccRef)[2][2][4][2];

struct EpiZ {
    static constexpr bool PERM = true;
    bf16_t* O; int ldc; const float* low; const f32x2* rope;
    __device__ __forceinline__ void operator()(AccRef acc, const Unit& u, int wr, int wc, int fr, int fq) const {
        const int row0 = u.pm * BM + wr * 64 + fr, col0 = u.pn * BM + wc * 32 + 8 * fq;
        const int mode = (u.pn >= 10 && u.pn < 14) ? 1 : ((u.pn >= 4 && u.pn < 8) ? 2 : (u.pn >= 14 ? 3 : 0));
        const bool rlane = ((wc & 1) == 0) && (fq < 2);
#pragma unroll
        for (int bj = 0; bj < 2; ++bj) {
            f32x4 l0 = (f32x4){0.f, 0.f, 0.f, 0.f}, l1 = l0;
            if (mode == 2) { const float* lp = low + (col0 + bj * HALF - 1024); l0 = *(const f32x4*)lp; l1 = *(const f32x4*)(lp + 4); }
#pragma unroll
            for (int ai = 0; ai < 2; ++ai)
#pragma unroll
                for (int m = 0; m < 4; ++m) { bf16_t* rowp = O + (size_t)(row0 + ai * HALF + m * 16) * ldc + col0;
                    f32x4 v0 = acc[ai][bj][m][0], v1 = acc[ai][bj][m][1];
                    if (mode == 1) {
#pragma unroll
                        for (int j = 0; j < 4; ++j) { v0[j] = gelu_tanh(v0[j]); v1[j] = gelu_tanh(v1[j]); }
                    } else if (mode == 2) {
#pragma unroll
                        for (int j = 0; j < 4; ++j) { v0[j] = __logf(l0[j] + (1.0f - l0[j]) * sigmoidf_(v0[j])); v1[j] = __logf(l1[j] + (1.0f - l1[j]) * sigmoidf_(v1[j])); }
                    } else if (mode == 3 && (u.pn < 16 || bj == 0)) {
                        f32x4 p0, p1;
#pragma unroll
                        for (int j = 0; j < 4; ++j) { p0[j] = __shfl_xor(v0[j], 16); p1[j] = __shfl_xor(v1[j], 16); }
                        if (rlane) {
                            const int pos = (row0 + ai * HALF + m * 16) & (SEQ - 1);
                            const f32x4* rp = (const f32x4*)(rope + (size_t)pos * 8);
                            const f32x4 r0 = rp[0], r1 = rp[1], r2 = rp[2], r3 = rp[3];
                            const float sg = fq == 0 ? -1.f : 1.f;
                            v0[0] = v0[0] * r0.x + sg * p0[0] * r0.y; v0[1] = v0[1] * r0.z + sg * p0[1] * r0.w; v0[2] = v0[2] * r1.x + sg * p0[2] * r1.y; v0[3] = v0[3] * r1.z + sg * p0[3] * r1.w;
                            v1[0] = v1[0] * r2.x + sg * p1[0] * r2.y; v1[1] = v1[1] * r2.z + sg * p1[1] * r2.w; v1[2] = v1[2] * r3.x + sg * p1[2] * r3.y; v1[3] = v1[3] * r3.z + sg * p1[3] * r3.w;
                        }
                    }
                    u32x4 w; w.x = cvt_pk_bf16(v0[0], v0[1]); w.y = cvt_pk_bf16(v0[2], v0[3]); w.z = cvt_pk_bf16(v1[0], v1[1]); w.w = cvt_pk_bf16(v1[2], v1[3]);
                    *(u32x4*)(rowp + bj * HALF) = w; }
        }
    }
};
template <int ACT  > struct EpiAct {
    static constexpr bool PERM = true;
    bf16_t* O; int ldc; const float* sumsq;
    __device__ __forceinline__ void operator()(AccRef acc, const Unit& u, int wr, int wc, int fr, int fq) const {
        const int row0 = u.pm * BM + wr * 64 + fr, col0 = u.pn * BM + wc * 32 + 8 * fq;
#pragma unroll
        for (int ai = 0; ai < 2; ++ai)
#pragma unroll
            for (int m = 0; m < 4; ++m) { bf16_t* rowp = O + (size_t)(row0 + ai * HALF + m * 16) * ldc + col0;
                float r2 = 1.f; if (ACT == 1) r2 = __builtin_amdgcn_rcpf(sumsq[row0 + ai * HALF + m * 16] * (1.f / D) + EPS);
#pragma unroll
                for (int bj = 0; bj < 2; ++bj) { f32x4 v0 = acc[ai][bj][m][0], v1 = acc[ai][bj][m][1];
#pragma unroll
                    for (int j = 0; j < 4; ++j) {
                        if (ACT == 0) { v0[j] = sigmoidf_(v0[j]); v1[j] = sigmoidf_(v1[j]); }
                        else { const float a = fmaxf(v0[j], 0.f), b = fmaxf(v1[j], 0.f); v0[j] = a * a * r2; v1[j] = b * b * r2; } }
                    u32x4 w; w.x = cvt_pk_bf16(v0[0], v0[1]); w.y = cvt_pk_bf16(v0[2], v0[3]); w.z = cvt_pk_bf16(v1[0], v1[1]); w.w = cvt_pk_bf16(v1[2], v1[3]);
                    *(u32x4*)(rowp + bj * HALF) = w; } }
    }
};
template <int MODE  > struct EpiMul {
    static constexpr bool PERM = true;
    bf16_t* Mg; const bf16_t* Sg; int ldc;
    __device__ __forceinline__ void operator()(AccRef acc, const Unit& u, int wr, int wc, int fr, int fq) const {
        const int row0 = u.pm * BM + wr * 64 + fr, col0 = u.pn * BM + wc * 32 + 8 * fq;
#pragma unroll
        for (int ai = 0; ai < 2; ++ai)
#pragma unroll
            for (int m = 0; m < 4; ++m) { const size_t off = (size_t)(row0 + ai * HALF + m * 16) * ldc + col0;
#pragma unroll
                for (int bj = 0; bj < 2; ++bj) { const f32x4 v0 = acc[ai][bj][m][0], v1 = acc[ai][bj][m][1];
                    const u32x4 mw = *(const u32x4*)(Mg + off + bj * HALF);
                    u32x4 w;
                    if (MODE == 0) {
                        w.x = cvt_pk_bf16(bf_lo(mw.x) * v0[0], bf_hi(mw.x) * v0[1]); w.y = cvt_pk_bf16(bf_lo(mw.y) * v0[2], bf_hi(mw.y) * v0[3]);
                        w.z = cvt_pk_bf16(bf_lo(mw.z) * v1[0], bf_hi(mw.z) * v1[1]); w.w = cvt_pk_bf16(bf_lo(mw.w) * v1[2], bf_hi(mw.w) * v1[3]);
                    } else {
                        const u32x4 sw = *(const u32x4*)(Sg + off + bj * HALF);
                        w.x = cvt_pk_bf16(bf_lo(mw.x) + bf_lo(sw.x) * v0[0], bf_hi(mw.x) + bf_hi(sw.x) * v0[1]); w.y = cvt_pk_bf16(bf_lo(mw.y) + bf_lo(sw.y) * v0[2], bf_hi(mw.y) + bf_hi(sw.y) * v0[3]);
                        w.z = cvt_pk_bf16(bf_lo(mw.z) + bf_lo(sw.z) * v1[0], bf_hi(mw.z) + bf_hi(sw.z) * v1[1]); w.w = cvt_pk_bf16(bf_lo(mw.w) + bf_lo(sw.w) * v1[2], bf_hi(mw.w) + bf_hi(sw.w) * v1[3]);
                    }
                    *(u32x4*)(Mg + off + bj * HALF) = w; }
                if (m & 1) asm volatile("" ::: "memory"); }
    }
};
template <bool SQ> struct EpiRes {
    static constexpr bool PERM = false;
    const float* base; float* out; int ldc; bf16_t* xb; float* sumsq;
    __device__ __forceinline__ void operator()(AccRef acc, const Unit& u, int wr, int wc, int fr, int fq) const {
        const int row0 = u.pm * BM + wr * 64 + fr, col0 = u.pn * BM + wc * 32 + 4 * fq;
#pragma unroll
        for (int ai = 0; ai < 2; ++ai)
#pragma unroll
            for (int m = 0; m < 4; ++m) { const int row = row0 + ai * HALF + m * 16; const size_t off = (size_t)row * ldc + col0; float ss = 0.f;
#pragma unroll
                for (int bj = 0; bj < 2; ++bj)
#pragma unroll
                    for (int n = 0; n < 2; ++n) { const f32x4 b = *(const f32x4*)(base + off + bj * HALF + n * 16); const f32x4 v = b + acc[ai][bj][m][n]; *(f32x4*)(out + off + bj * HALF + n * 16) = v;
                        if (SQ) { ss += (v[0] * v[0] + v[1] * v[1]) + (v[2] * v[2] + v[3] * v[3]); u32x2 w; w.x = cvt_pk_bf16(v[0], v[1]); w.y = cvt_pk_bf16(v[2], v[3]); *(u32x2*)(xb + off + bj * HALF + n * 16) = w; } }
                if (SQ) { ss += __shfl_xor(ss, 16); ss += __shfl_xor(ss, 32); if (fq == 0) __hip_atomic_fetch_add(sumsq + row, ss, __ATOMIC_RELAXED, __HIP_MEMORY_SCOPE_AGENT); }
                if (m & 1) asm volatile("" ::: "memory"); }
    }
};

template <class Epi>
__device__ __forceinline__ void gemm_phase(LAS unsigned char* lds, const Gemm g, const StaticOrder& S, const Epi& E, const int tid) {
    const int wid = __builtin_amdgcn_readfirstlane(tid >> 6), lane = tid & 63, wr = wid >> 2, wc = wid & 3, fr = lane & 15, fq = lane >> 4;
    const int K = g.K, nt = K / BK;
    unsigned voffA[2], voffB[2];
#pragma unroll
    for (int i = 0; i < 2; ++i) { int R, C; stage_rc(tid * 16 + i * 8192, R, C); const int Rb = Epi::PERM ? ((R & ~31) + perm32(R & 31)) : R;
        voffA[i] = (unsigned)(R * g.lda + C) * 2u; voffB[i] = (unsigned)(Rb * K + C) * 2u; }
    const size_t kstep = (size_t)(BK * 2);
    const size_t hstepA = (size_t)HALF * g.lda * 2, hstepB = (size_t)HALF * K * 2;
    const size_t tstepA = 2 * hstepA, tstepB = 2 * hstepB;
    const unsigned ldsw = (unsigned)wid * 1024u;
    const int aoff = lds_byte(wr * 64 + fr, fq * 8), boff = lds_byte(wc * 32 + fr, fq * 8);
#define PG8_SA(b, h) (((b) * 2 + (h)) * HTB)
#define PG8_SB(b, h) ((4 + (b) * 2 + (h)) * HTB)
#define PG8_STAGE(bufoff, gbase, voff) do { _Pragma("unroll") for (int _i = 0; _i < 2; ++_i) \
        __builtin_amdgcn_global_load_lds((const unsigned*)((const char*)(gbase) + (voff)[_i]), (LAS unsigned*)(lds + (bufoff) + ldsw + _i * 8192), 16, 0, 0); } while (0)
#define PG8_LDA(dst, b, h) do { _Pragma("unroll") for (int m = 0; m < 4; ++m) _Pragma("unroll") for (int k = 0; k < 2; ++k) dst[m][k] = *(const LAS bf16x8*)(lds + PG8_SA(b, h) + aoff + m * 2048 + k * 1024); } while (0)
#define PG8_LDB(dst, b, h) do { _Pragma("unroll") for (int n = 0; n < 2; ++n) _Pragma("unroll") for (int k = 0; k < 2; ++k) dst[n][k] = *(const LAS bf16x8*)(lds + PG8_SB(b, h) + boff + n * 2048 + k * 1024); } while (0)
#define PG8_MMA(ai, bj, At, Bt) do { __builtin_amdgcn_s_setprio(1); _Pragma("unroll") for (int m = 0; m < 4; ++m) _Pragma("unroll") for (int n = 0; n < 2; ++n) _Pragma("unroll") for (int k = 0; k < 2; ++k) \
        acc[ai][bj][m][n] = __builtin_amdgcn_mfma_f32_16x16x32_bf16(Bt[n][k], At[m][k], acc[ai][bj][m][n], 0, 0, 0); __builtin_amdgcn_s_setprio(0); } while (0)
#define PG8_WAIT_V(n) asm volatile("s_waitcnt vmcnt(" #n ")" ::: "memory")
#define PG8_WAIT_L(n) asm volatile("s_waitcnt lgkmcnt(" #n ")" ::: "memory")
#define PG8_BAR __builtin_amdgcn_s_barrier()
#define PG8_SCHED __builtin_amdgcn_sched_barrier(0)
    Unit cur, nxt; int ui = 0;
    if (!S.next(0, cur)) return;
    f32x4 acc[2][2][4][2];
#pragma unroll
    for (int a = 0; a < 2; ++a)
#pragma unroll
        for (int b = 0; b < 2; ++b)
#pragma unroll
            for (int m = 0; m < 4; ++m)
#pragma unroll
                for (int n = 0; n < 2; ++n) acc[a][b][m][n] = (f32x4){0.f, 0.f, 0.f, 0.f};
    bf16x8 At[4][2], B0[2][2], B1[2][2];
    const char* cA = (const char*)g.A + (size_t)cur.pm * tstepA; const char* cB = (const char*)g.Bt + (size_t)cur.pn * tstepB;
    PG8_STAGE(PG8_SB(0, 0), cB, voffB); PG8_STAGE(PG8_SB(0, 1), cB + hstepB, voffB); PG8_STAGE(PG8_SA(0, 0), cA, voffA); PG8_STAGE(PG8_SA(0, 1), cA + hstepA, voffA);
    if (wr == 1) PG8_BAR;
    PG8_WAIT_V(2); PG8_BAR;
    PG8_STAGE(PG8_SB(1, 0), cB + kstep, voffB); PG8_STAGE(PG8_SA(1, 0), cA + kstep, voffA); PG8_STAGE(PG8_SB(1, 1), cB + hstepB + kstep, voffB);
    PG8_WAIT_V(6); PG8_BAR;
    for (;;) {
        const bool has_next = S.next(ui + 1, nxt);
        const char* nA = has_next ? (const char*)g.A + (size_t)nxt.pm * tstepA : cA; const char* nB = has_next ? (const char*)g.Bt + (size_t)nxt.pn * tstepB : cB;
        for (int t = 0; t < nt; t += 2) {
            const bool last = (t == nt - 2);
            const char* a1 = cA + (size_t)(t + 1) * kstep;
            const char* a2 = last ? nA : cA + (size_t)(t + 2) * kstep; const char* b2 = last ? nB : cB + (size_t)(t + 2) * kstep;
            const char* a3 = a2 + kstep; const char* b3 = b2 + kstep;
            PG8_LDB(B0, 0, 0); PG8_LDB(B1, 0, 1); PG8_SCHED; PG8_LDA(At, 0, 0); PG8_STAGE(PG8_SA(1, 1), a1 + hstepA, voffA);
            PG8_WAIT_V(8); PG8_WAIT_L(0); PG8_BAR; PG8_MMA(0, 0, At, B0); PG8_MMA(0, 1, At, B1); PG8_BAR; PG8_SCHED;
            PG8_LDA(At, 0, 1); PG8_STAGE(PG8_SB(0, 0), b2, voffB); PG8_STAGE(PG8_SB(0, 1), b2 + hstepB, voffB); PG8_STAGE(PG8_SA(0, 0), a2, voffA);
            PG8_WAIT_V(8); PG8_WAIT_L(0); PG8_BAR; PG8_MMA(1, 0, At, B0); PG8_MMA(1, 1, At, B1); PG8_BAR; PG8_SCHED;
            PG8_LDB(B0, 1, 0); PG8_LDB(B1, 1, 1); PG8_SCHED; PG8_LDA(At, 1, 0); PG8_STAGE(PG8_SA(0, 1), a2 + hstepA, voffA);
            PG8_WAIT_V(8); PG8_WAIT_L(0); PG8_BAR; PG8_MMA(0, 0, At, B0); PG8_MMA(0, 1, At, B1); PG8_BAR; PG8_SCHED;
            PG8_LDA(At, 1, 1); PG8_STAGE(PG8_SB(1, 0), b3, voffB); PG8_STAGE(PG8_SB(1, 1), b3 + hstepB, voffB); PG8_STAGE(PG8_SA(1, 0), a3, voffA);
            PG8_WAIT_V(8); PG8_WAIT_L(0); PG8_BAR; PG8_MMA(1, 0, At, B0); PG8_MMA(1, 1, At, B1); PG8_BAR; PG8_SCHED;
        }
        if (wr == 0) PG8_BAR;
        E(acc, cur, wr, wc, fr, fq);
        if (!has_next) break;
#pragma unroll
        for (int a = 0; a < 2; ++a)
#pragma unroll
            for (int b = 0; b < 2; ++b)
#pragma unroll
                for (int m = 0; m < 4; ++m)
#pragma unroll
                    for (int n = 0; n < 2; ++n) acc[a][b][m][n] = (f32x4){0.f, 0.f, 0.f, 0.f};
        cur = nxt; cA = nA; cB = nB; ++ui;
        if (wr == 1) PG8_BAR;
    }
    PG8_WAIT_V(0);
    PG8_BAR;
#undef PG8_SA
#undef PG8_SB
#undef PG8_STAGE
#undef PG8_LDA
#undef PG8_LDB
#undef PG8_MMA
#undef PG8_WAIT_V
#undef PG8_WAIT_L
#undef PG8_BAR
#undef PG8_SCHED
}
}

struct Ctx { unsigned char* lds; int tid, lane, wave, bid, G; };
__device__ __forceinline__ Ctx make_ctx(unsigned char* lds) { int tid = threadIdx.x; asm volatile("" : "+v"(tid)); Ctx c; c.lds = lds; c.tid = tid; c.lane = tid & 63; c.wave = __builtin_amdgcn_readfirstlane(tid >> 6); c.bid = blockIdx.x; c.G = gridDim.x; return c; }

__device__ __forceinline__ void transpose_item(const float* W, int K, int N, bf16_t* WT, float* scr, int item, int lane, const float* kscale = nullptr) {
    const int nblk = N / 32, kb = item / nblk, nb = item % nblk, k0 = 64 * kb, n0 = 32 * nb;
#pragma unroll 8
    for (int i = 0; i < 32; ++i) { const int kk = 2 * i + (lane >> 5); scr[kk * 33 + (lane & 31)] = W[(size_t)(k0 + kk) * N + n0 + (lane & 31)] * (kscale ? kscale[k0 + kk] : 1.f); }
    asm volatile("s_waitcnt lgkmcnt(0)" ::: "memory");
    const int c = lane & 7;
#pragma unroll
    for (int j = 0; j < 4; ++j) { const int n = (lane >> 3) + 8 * j; const float* s = scr + (8 * c) * 33 + n;
        u32x4 o; o.x = cvt_pk_bf16(s[0 * 33], s[1 * 33]); o.y = cvt_pk_bf16(s[2 * 33], s[3 * 33]); o.z = cvt_pk_bf16(s[4 * 33], s[5 * 33]); o.w = cvt_pk_bf16(s[6 * 33], s[7 * 33]);
        *(u32x4*)(WT + (size_t)(n0 + n) * K + k0 + 8 * c) = o; }
    asm volatile("s_waitcnt lgkmcnt(0)" ::: "memory");
}

__device__ __forceinline__ void rms_rows_bf16(const Ctx& c, const float* src, const float* w, bf16_t* dst, int ldo) {
    const int gw = c.bid * 8 + c.wave, NGW = c.G * 8;
    f32x4 wv[4];
#pragma unroll
    for (int j = 0; j < 4; ++j) wv[j] = *((const f32x4*)w + c.lane + 64 * j);
    for (int m = gw; m < T; m += NGW) {
        const f32x4* xr = (const f32x4*)(src + (size_t)m * D) + c.lane;
        f32x4 v[4]; float s = 0.f;
#pragma unroll
        for (int j = 0; j < 4; ++j) { v[j] = xr[64 * j]; s += (v[j].x * v[j].x + v[j].y * v[j].y) + (v[j].z * v[j].z + v[j].w * v[j].w); }
        const float rstd = rsqrtf(wave_sum(s) * (1.f / D) + EPS);
        u32x2* o8 = (u32x2*)(dst + (size_t)m * ldo) + c.lane;
#pragma unroll
        for (int j = 0; j < 4; ++j) { u32x2 o; o.x = cvt_pk_bf16(v[j].x * rstd * wv[j].x, v[j].y * rstd * wv[j].y); o.y = cvt_pk_bf16(v[j].z * rstd * wv[j].z, v[j].w * rstd * wv[j].w); o8[64 * j] = o; }
    }
}
__device__ __forceinline__ void rms_rows_f32_inplace(const Ctx& c, float* x, const float* w) {
    const int gw = c.bid * 8 + c.wave, NGW = c.G * 8;
    f32x4 wv[4];
#pragma unroll
    for (int j = 0; j < 4; ++j) wv[j] = *((const f32x4*)w + c.lane + 64 * j);
    for (int m = gw; m < T; m += NGW) {
        f32x4* xr = (f32x4*)(x + (size_t)m * D) + c.lane;
        f32x4 v[4]; float s = 0.f;
#pragma unroll
        for (int j = 0; j < 4; ++j) { v[j] = xr[64 * j]; s += (v[j].x * v[j].x + v[j].y * v[j].y) + (v[j].z * v[j].z + v[j].w * v[j].w); }
        const float rstd = rsqrtf(wave_sum(s) * (1.f / D) + EPS);
#pragma unroll
        for (int j = 0; j < 4; ++j) xr[64 * j] = v[j] * rstd * wv[j];
    }
}

__device__ __forceinline__ float lower_bound_of(const float* lb_logits, int l, int dir, int col) {
    if (l == 0) return 0.f;
    const float l0 = lb_logits[dir * 512 + col], l1 = lb_logits[1024 + dir * 512 + col];
    return 1.0f / (1.0f + __expf(l0 - l1));
}

__device__ __forceinline__ void phase_pre(const Ctx& c, int l, const float* in1, const float* in2, const float* in3, const float* in5, const float* in8, const float* in9, const float* in10, const float* in11, const float* in12, const float* xsrc, unsigned char* ws) {
    float* scr = (float*)(c.lds + c.wave * 8704);
    const int gw = c.bid * 8 + c.wave, NGW = c.G * 8;
    bf16_t* Wb = (bf16_t*)(ws + WS_W);
    const float* w_in = in1 + (size_t)l * D * DIN; const float* w_br = in8 + (size_t)l * 3 * 512 * D; const float* w_out = in9 + (size_t)l * D * D;
    const float* w_up = in11 + (size_t)l * D * DFF; const float* w_dn = in12 + (size_t)l * DFF * D;
    constexpr int I_IN = (D / 64) * (DIN / 32), I_BR = (512 / 64) * (D / 32), I_OUT = (D / 64) * (D / 32), I_UP = (D / 64) * (DFF / 32), I_DN = (DFF / 64) * (D / 32);
    constexpr int NITEMS = I_IN + 3 * I_BR + I_OUT + I_UP + I_DN;
    for (int it = gw; it < NITEMS; it += NGW) {
        int r = it;
        if (r < I_IN) { transpose_item(w_in, D, DIN, (bf16_t*)((char*)Wb + W_IN), scr, r, c.lane); continue; } r -= I_IN;
        if (r < 3 * I_BR) { const int b = r / I_BR; transpose_item(w_br + (size_t)b * 512 * D, 512, D, (bf16_t*)((char*)Wb + W_BR) + (size_t)b * D * 512, scr, r % I_BR, c.lane); continue; } r -= 3 * I_BR;
        if (r < I_OUT) { transpose_item(w_out, D, D, (bf16_t*)((char*)Wb + W_OUT), scr, r, c.lane); continue; } r -= I_OUT;
        if (r < I_UP) { transpose_item(w_up, D, DFF, (bf16_t*)((char*)Wb + W_UP), scr, r, c.lane, in10 + (size_t)l * D); continue; } r -= I_UP;
        transpose_item(w_dn, DFF, D, (bf16_t*)((char*)Wb + W_DN), scr, r, c.lane);
    }
    const int gt = c.bid * 512 + c.tid, NGT = c.G * 512;
    {
        const float* wsrc = in5 + (size_t)l * 4 * 128 * 128; bf16_t* wd = (bf16_t*)(ws + WS_WSB);
        for (int i = gt; i < 4 * 128 * 128; i += NGT) wd[i] = f2bf(wsrc[i]);
    }
    {   float* sq = (float*)(ws + WS_SUMSQ); for (int i = gt; i < T; i += NGT) sq[i] = 0.f; }
    {
        float* low = (float*)(ws + WS_LOW);
        for (int i = gt; i < 1024; i += NGT) low[i] = lower_bound_of(in3, l, i >> 9, i & 511);
    }
    if (l == 0) {
        f32x2* rt = (f32x2*)(ws + WS_ROPE);
        for (int i = gt; i < SEQ * 8; i += NGT) {
            const int pos = i >> 3, j = i & 7;
            const float inv = j == 0 ? 1.0f : j == 1 ? 0.1939227432012558f : j == 2 ? 0.03760603070259094f : j == 3 ? 0.007292664609849453f : j == 4 ? 0.0014142135623842478f : j == 5 ? 0.00027424818836152554f : j == 6 ? 5.318296098266728e-05f : 1.0313386155758053e-05f;
            const float ang = (float)pos * inv;
            const double rev = (double)ang * 0.15915494309189535; const double fr = rev - __builtin_rint(rev);
            const float f = (float)fr;
            rt[i] = (f32x2){__builtin_amdgcn_cosf(f), __builtin_amdgcn_sinf(f)};
        }
    }
    rms_rows_bf16(c, xsrc, in2 + (size_t)l * D, (bf16_t*)(ws + WS_Z) + ZXN, LDZ);
}

__device__ __forceinline__ void branch_b_unit(const Ctx& c, bf16_t* Z, const bf16_t* WSB, const float* bs, int unit) {
    constexpr int VP = 136;
    bf16_t* vnT = (bf16_t*)c.lds;
    bf16_t* zrow0 = Z + (size_t)unit * 128 * LDZ;
    const int fr = c.lane & 15, fq = c.lane >> 4;
    {
        const int p = c.wave * 16 + fr;
        const bf16_t* src = zrow0 + (size_t)p * LDZ + ZV + fq * 128;
        u32x4 raw[16]; float s = 0.f;
#pragma unroll
        for (int i = 0; i < 16; ++i) { raw[i] = *(const u32x4*)(src + i * 8);
            s += (bf_lo(raw[i].x) + bf_hi(raw[i].x)) + (bf_lo(raw[i].y) + bf_hi(raw[i].y)) + (bf_lo(raw[i].z) + bf_hi(raw[i].z)) + (bf_lo(raw[i].w) + bf_hi(raw[i].w)); }
        s += __shfl_xor(s, 16); s += __shfl_xor(s, 32);
        const float mean = s * (1.f / 512.f); float q = 0.f;
#pragma unroll
        for (int i = 0; i < 16; ++i) {
            float d;
            d = bf_lo(raw[i].x) - mean; q += d * d; d = bf_hi(raw[i].x) - mean; q += d * d; d = bf_lo(raw[i].y) - mean; q += d * d; d = bf_hi(raw[i].y) - mean; q += d * d;
            d = bf_lo(raw[i].z) - mean; q += d * d; d = bf_hi(raw[i].z) - mean; q += d * d; d = bf_lo(raw[i].w) - mean; q += d * d; d = bf_hi(raw[i].w) - mean; q += d * d; }
        q += __shfl_xor(q, 16); q += __shfl_xor(q, 32);
        const float rstd = rsqrtf(q * (1.f / 512.f) + EPS);
        bf16_t* dst = vnT + (size_t)(fq * 128) * VP + p;
#pragma unroll
        for (int i = 0; i < 16; ++i) {
            dst[(i * 8 + 0) * VP] = f2bf((bf_lo(raw[i].x) - mean) * rstd); dst[(i * 8 + 1) * VP] = f2bf((bf_hi(raw[i].x) - mean) * rstd);
            dst[(i * 8 + 2) * VP] = f2bf((bf_lo(raw[i].y) - mean) * rstd); dst[(i * 8 + 3) * VP] = f2bf((bf_hi(raw[i].y) - mean) * rstd);
            dst[(i * 8 + 4) * VP] = f2bf((bf_lo(raw[i].z) - mean) * rstd); dst[(i * 8 + 5) * VP] = f2bf((bf_hi(raw[i].z) - mean) * rstd);
            dst[(i * 8 + 6) * VP] = f2bf((bf_lo(raw[i].w) - mean) * rstd); dst[(i * 8 + 7) * VP] = f2bf((bf_hi(raw[i].w) - mean) * rstd); }
    }
    __syncthreads();
    const int q = c.wave * 16 + fr;
#pragma unroll 1
    for (int g = 0; g < 4; ++g) {
        bf16x8 wf[4];
#pragma unroll
        for (int kk = 0; kk < 4; ++kk) wf[kk] = *(const bf16x8*)(WSB + (size_t)(g * 128 + q) * 128 + kk * 32 + fq * 8);
        const float bias = bs[g * 128 + q];
        bf16_t* ub = zrow0 + (size_t)q * LDZ + ZU + g * 128 + fq * 4;
        u32x2 uu[8];
#pragma unroll
        for (int ct = 0; ct < 8; ++ct) uu[ct] = *(const u32x2*)(ub + ct * 16);
#pragma unroll
        for (int ct = 0; ct < 8; ++ct) {
            f32x4 acc = (f32x4){0.f, 0.f, 0.f, 0.f};
#pragma unroll
            for (int kk = 0; kk < 4; ++kk) { const bf16x8 a = *(const bf16x8*)(vnT + (size_t)(g * 128 + ct * 16 + fr) * VP + kk * 32 + fq * 8); acc = __builtin_amdgcn_mfma_f32_16x16x32_bf16(a, wf[kk], acc, 0, 0, 0); }
            u32x2 o; o.x = cvt_pk_bf16(bf_lo(uu[ct].x) * (acc[0] + bias), bf_hi(uu[ct].x) * (acc[1] + bias)); o.y = cvt_pk_bf16(bf_lo(uu[ct].y) * (acc[2] + bias), bf_hi(uu[ct].y) * (acc[3] + bias));
            *(u32x2*)(ub + ct * 16) = o;
        }
    }
    __syncthreads();
}

__device__ __forceinline__ void branch_c_unit(const Ctx& c, bf16_t* Z, const float* sink, int unit) {
    constexpr int KP = 72, VTP = 408;
    bf16_t* Ks = (bf16_t*)c.lds;
    bf16_t* Vt = (bf16_t*)(c.lds + 400 * KP * 2);
    const int hk = unit & 1, n = (unit >> 1) & 63, b = unit >> 7;
    const int fr = c.lane & 15, fq = c.lane >> 4;
    const size_t rowb = (size_t)b * SEQ;
    const int g = c.wave >> 1, half = c.wave & 1, head = hk * 4 + g;
    bf16_t* qrow0 = Z + (rowb + n * 128 + half * 64 + fr) * LDZ + ZCQ + head * 64;
    u32x4 qa[4], qb[4];
#pragma unroll
    for (int qt = 0; qt < 4; ++qt) { qa[qt] = *(const u32x4*)(qrow0 + (size_t)qt * 16 * LDZ + fq * 8); qb[qt] = *(const u32x4*)(qrow0 + (size_t)qt * 16 * LDZ + 32 + fq * 8); }
    {
        u32x4 kv[7], vv[7];
#pragma unroll
        for (int it = 0; it < 7; ++it) {
            const int chunk = c.tid + 512 * it; const int row = chunk >> 3, part = chunk & 7;
            const int tk = (n - 1) * 128 + row;
            const bool valid = row < 384 && tk >= 0 && tk < SEQ;
            kv[it] = (u32x4){0u, 0u, 0u, 0u}; vv[it] = (u32x4){0u, 0u, 0u, 0u};
            if (valid) { const bf16_t* zr = Z + (rowb + tk) * LDZ; kv[it] = *(const u32x4*)(zr + ZCK + hk * 64 + part * 8); vv[it] = *(const u32x4*)(zr + ZCV + hk * 64 + part * 8); }
        }
#pragma unroll
        for (int it = 0; it < 7; ++it) {
            const int chunk = c.tid + 512 * it; const int row = chunk >> 3, part = chunk & 7;
            if (row < 400) {
                *(u32x4*)(Ks + row * KP + part * 8) = kv[it];
                bf16_t* vd = Vt + (part * 8) * VTP + row;
                vd[0 * VTP] = (bf16_t)(vv[it].x & 0xffffu); vd[1 * VTP] = (bf16_t)(vv[it].x >> 16); vd[2 * VTP] = (bf16_t)(vv[it].y & 0xffffu); vd[3 * VTP] = (bf16_t)(vv[it].y >> 16);
                vd[4 * VTP] = (bf16_t)(vv[it].z & 0xffffu); vd[5 * VTP] = (bf16_t)(vv[it].z >> 16); vd[6 * VTP] = (bf16_t)(vv[it].w & 0xffffu); vd[7 * VTP] = (bf16_t)(vv[it].w >> 16);
            }
        }
    }
    __syncthreads();
    const float sk = sink[head];
    const int base = fq * 4 - fr;
#pragma unroll
    for (int qt = 0; qt < 4; ++qt) {
        const int q0 = half * 64 + qt * 16;
        const bf16x8 qf0 = __builtin_bit_cast(bf16x8, qa[qt]), qf1 = __builtin_bit_cast(bf16x8, qb[qt]);
        const int kt0 = q0 >> 4;
        f32x4 s[17]; float mx = sk;
#pragma unroll
        for (int tt = 0; tt < 17; ++tt) {
            const int kt = kt0 + tt;
            const bool tile_ok = !((n == 0 && kt < 8) || (n == 63 && kt >= 16));
            f32x4 a = (f32x4){-1e30f, -1e30f, -1e30f, -1e30f};
            if (tile_ok) {
                const bf16_t* kr = Ks + (kt * 16 + fr) * KP + fq * 8;
                a = (f32x4){0.f, 0.f, 0.f, 0.f};
                a = __builtin_amdgcn_mfma_f32_16x16x32_bf16(*(const bf16x8*)kr, qf0, a, 0, 0, 0);
                a = __builtin_amdgcn_mfma_f32_16x16x32_bf16(*(const bf16x8*)(kr + 32), qf1, a, 0, 0, 0);
#pragma unroll
                for (int j = 0; j < 4; ++j) {
                    float v = a[j] * 0.125f;
                    if (tt == 0) v = (base + j >= 0) ? v : -1e30f;
                    if (tt == 16) v = (base + j <= 0) ? v : -1e30f;
                    a[j] = v; mx = fmaxf(mx, v);
                }
            }
            s[tt] = a;
        }
        mx = fmaxf(mx, __shfl_xor(mx, 16)); mx = fmaxf(mx, __shfl_xor(mx, 32));
        float lsum = 0.f;
#pragma unroll
        for (int tt = 0; tt < 17; ++tt)
#pragma unroll
            for (int j = 0; j < 4; ++j) { const float p = __expf(s[tt][j] - mx); s[tt][j] = p; lsum += p; }
        lsum += __shfl_xor(lsum, 16); lsum += __shfl_xor(lsum, 32);
        lsum += __expf(sk - mx);
        const float rl = __builtin_amdgcn_rcpf(lsum);
        f32x4 o[4];
#pragma unroll
        for (int dt = 0; dt < 4; ++dt) o[dt] = (f32x4){0.f, 0.f, 0.f, 0.f};
#pragma unroll
        for (int kk = 0; kk < 9; ++kk) {
            u32x4 pw; pw.x = cvt_pk_bf16(s[2 * kk][0], s[2 * kk][1]); pw.y = cvt_pk_bf16(s[2 * kk][2], s[2 * kk][3]);
            if (kk < 8) { pw.z = cvt_pk_bf16(s[2 * kk + 1][0], s[2 * kk + 1][1]); pw.w = cvt_pk_bf16(s[2 * kk + 1][2], s[2 * kk + 1][3]); } else { pw.z = 0u; pw.w = 0u; }
            const bf16x8 pf = __builtin_bit_cast(bf16x8, pw);
#pragma unroll
            for (int dt = 0; dt < 4; ++dt) {
                const bf16_t* vr = Vt + (dt * 16 + fr) * VTP + (kt0 + 2 * kk) * 16 + fq * 4;
                u32x4 vw; const u32x2 v0 = *(const u32x2*)vr, v1 = *(const u32x2*)(vr + 16); vw.x = v0.x; vw.y = v0.y; vw.z = v1.x; vw.w = v1.y;
                o[dt] = __builtin_amdgcn_mfma_f32_16x16x32_bf16(__builtin_bit_cast(bf16x8, vw), pf, o[dt], 0, 0, 0);
            }
        }
        bf16_t* qrow = qrow0 + (size_t)qt * 16 * LDZ;
#pragma unroll
        for (int dt = 0; dt < 4; ++dt) { u32x2 w; w.x = cvt_pk_bf16(o[dt][0] * rl, o[dt][1] * rl); w.y = cvt_pk_bf16(o[dt][2] * rl, o[dt][3] * rl); *(u32x2*)(qrow + dt * 16 + fq * 4) = w; }
    }
    __syncthreads();
}

__device__ __forceinline__ void stage_tile64x128(bf16_t* dst  , const bf16_t* src  , int tid) {
#pragma unroll
    for (int i = 0; i < 2; ++i) { const int chunk = tid + 512 * i; const int s = chunk >> 4, part = chunk & 15;
        *(u32x4*)(dst + s * 136 + part * 8) = *(const u32x4*)(src + (size_t)s * LDZ + part * 8); }
}
__device__ __forceinline__ void stage_vt(bf16_t* Vt  , const bf16_t* src, int tid) {
    constexpr int SP = 72;
#pragma unroll
    for (int i = 0; i < 2; ++i) { const int chunk = tid + 512 * i; const int s = chunk >> 4, part = chunk & 15;
        const u32x4 vv = *(const u32x4*)(src + (size_t)s * LDZ + part * 8);
        bf16_t* vd = Vt + (part * 8) * SP + (s ^ ((part & 7) << 3));
        vd[0 * SP] = (bf16_t)(vv.x & 0xffffu); vd[1 * SP] = (bf16_t)(vv.x >> 16); vd[2 * SP] = (bf16_t)(vv.y & 0xffffu); vd[3 * SP] = (bf16_t)(vv.y >> 16);
        vd[4 * SP] = (bf16_t)(vv.z & 0xffffu); vd[5 * SP] = (bf16_t)(vv.z >> 16); vd[6 * SP] = (bf16_t)(vv.w & 0xffffu); vd[7 * SP] = (bf16_t)(vv.w >> 16); }
}
__device__ __forceinline__ float gate_cumsum(float (&gl)[32], float (&ky)[32], int dir) {
#pragma unroll
    for (int i = 0; i < 32; ++i) ky[i] = 1.0f - __expf(gl[i]);
    float run = 0.f;
    if (dir == 0) {
#pragma unroll
        for (int i = 0; i < 32; ++i) { run += gl[i]; gl[i] = run; }
    } else {
#pragma unroll
        for (int i = 31; i >= 0; --i) { run += gl[i]; gl[i] = run; }
    }
    return run;
}
__device__ __forceinline__ void hgrn_pass1_unit(const Ctx& c, const bf16_t* Z, bf16_t* Lg, float* DEC, float* ENR, int unit) {
    constexpr int SP = 72, QP = 136;
    bf16_t* Raw = (bf16_t*)c.lds;
    bf16_t* KdT = (bf16_t*)c.lds;
    bf16_t* Vt = (bf16_t*)(c.lds + 2 * 128 * SP * 2);
    float* tot = (float*)(c.lds + 3 * 128 * SP * 2);
    const int ch = unit & 127, h = (unit >> 7) & 3, b = unit >> 9;
    const size_t row0 = (size_t)b * SEQ + (size_t)ch * 64;
    const int dir = c.tid >> 8, half = (c.tid >> 7) & 1, k = c.tid & 127;
    const bf16_t* zt = Z + row0 * LDZ + h * 128;
    stage_tile64x128(Raw, zt + ZFF, c.tid); stage_tile64x128(Raw + 64 * QP, zt + ZFB, c.tid); stage_vt(Vt, zt + ZI, c.tid);
    __syncthreads();
    float gl[32], ky[32];
    {
        const bf16_t* zr = Raw + (dir * 64 + half * 32) * QP + k;
#pragma unroll
        for (int i = 0; i < 32; ++i) gl[i] = bf2f(zr[i * QP]);
    }
    const float run = gate_cumsum(gl, ky, dir);
    tot[(dir * 2 + half) * 128 + k] = run;
    __syncthreads();
    const bool near = (half == dir);
    const float tother = tot[(dir * 2 + (half ^ 1)) * 128 + k];
    const float add = run + (near ? tother : 0.f);
    if (near) { const size_t di = ((size_t)((dir * 16 + b * 4 + h) * 128 + (dir ? 127 - ch : ch))) * 128 + k; DEC[di] = __expf(run + tother); ENR[di] = __expf(run); }
    {
        unsigned pkd[16];
#pragma unroll
        for (int i = 0; i < 32; i += 2) pkd[i >> 1] = cvt_pk_bf16(ky[i] * __expf(add - gl[i]), ky[i + 1] * __expf(add - gl[i + 1]));
        u32x4* dst = (u32x4*)(KdT + (dir * 128 + k) * SP + half * 32);
#pragma unroll
        for (int w = 0; w < 4; ++w) dst[w] = (u32x4){pkd[4 * w], pkd[4 * w + 1], pkd[4 * w + 2], pkd[4 * w + 3]};
    }
    __syncthreads();
    {
        const int fr = c.lane & 15, fq = c.lane >> 4;
        const int wd = c.wave >> 2, kq = c.wave & 3;
        bf16_t* Lo = Lg + ((size_t)((wd * 16 + b * 4 + h) * 128 + (wd ? 127 - ch : ch))) * 128 * 128;
#pragma unroll
        for (int kt = 0; kt < 2; ++kt) {
            const bf16_t* ar = KdT + (wd * 128 + kq * 32 + kt * 16 + fr) * SP + fq * 8;
            const bf16x8 a0 = *(const bf16x8*)ar, a1 = *(const bf16x8*)(ar + 32);
#pragma unroll
            for (int vt = 0; vt < 8; ++vt) {
                const int vx = (((vt * 16 + fr) >> 3) & 7) << 3;
                const bf16_t* br = Vt + (vt * 16 + fr) * SP;
                f32x4 acc = (f32x4){0.f, 0.f, 0.f, 0.f};
                acc = __builtin_amdgcn_mfma_f32_16x16x32_bf16(a0, *(const bf16x8*)(br + ((fq * 8) ^ vx)), acc, 0, 0, 0);
                acc = __builtin_amdgcn_mfma_f32_16x16x32_bf16(a1, *(const bf16x8*)(br + ((fq * 8 + 32) ^ vx)), acc, 0, 0, 0);
                u32x2 w; w.x = cvt_pk_bf16(acc[0], acc[1]); w.y = cvt_pk_bf16(acc[2], acc[3]);
                *(u32x2*)(Lo + (size_t)(vt * 16 + fr) * 128 + kq * 32 + kt * 16 + fq * 4) = w;
            }
        }
    }
    __syncthreads();
}

__device__ __forceinline__ void hgrn_scan(const Ctx& c, bf16_t* Lg, const float* DEC, const float* ENR) {
    for (int idx = c.bid * 512 + c.tid; idx < 32 * 128 * 32; idx += c.G * 512) {
        const int k4 = idx & 31, v = (idx >> 5) & 127, seq = idx >> 12;
        bf16_t* lp = Lg + (size_t)seq * 128 * 16384 + (size_t)v * 128 + k4 * 4;
        const float* dp = DEC + (size_t)seq * 128 * 128 + k4 * 4;
        const float* ep = ENR + (size_t)seq * 128 * 128 + k4 * 4;
        f32x4 st = (f32x4){0.f, 0.f, 0.f, 0.f};
#pragma unroll 1
        for (int c0 = 0; c0 < 128; c0 += 8) {
            u32x2 lw[8]; f32x4 dd[8], ee[8];
#pragma unroll
            for (int i = 0; i < 8; ++i) { lw[i] = *(const u32x2*)(lp + (size_t)(c0 + i) * 16384); dd[i] = *(const f32x4*)(dp + (size_t)(c0 + i) * 128); ee[i] = *(const f32x4*)(ep + (size_t)(c0 + i) * 128); }
#pragma unroll
            for (int i = 0; i < 8; ++i) {
                u32x2 o; o.x = cvt_pk_bf16(st[0] * ee[i][0], st[1] * ee[i][1]); o.y = cvt_pk_bf16(st[2] * ee[i][2], st[3] * ee[i][3]);
                *(u32x2*)(lp + (size_t)(c0 + i) * 16384) = o;
                st[0] = dd[i][0] * st[0] + bf_lo(lw[i].x); st[1] = dd[i][1] * st[1] + bf_hi(lw[i].x); st[2] = dd[i][2] * st[2] + bf_lo(lw[i].y); st[3] = dd[i][3] * st[3] + bf_hi(lw[i].y);
            }
        }
    }
}

__device__ __forceinline__ void hgrn_pass3_unit(const Ctx& c, bf16_t* Z, const float* a_norm, const bf16_t* Lg, int unit, int ocol) {
    constexpr int QP = 136, SP = 72;
    bf16_t* Qp = (bf16_t*)c.lds;
    bf16_t* Kp = Qp + 2 * 64 * QP;
    bf16_t* Vt = Kp + 2 * 64 * QP;
    float* tot = (float*)(Vt + 128 * SP);
    float* red = tot + 512;
    const int ch = unit & 127, h = (unit >> 7) & 3, b = unit >> 9;
    const size_t row0 = (size_t)b * SEQ + (size_t)ch * 64;
    {
        const int dir = c.tid >> 8, half = (c.tid >> 7) & 1, k = c.tid & 127;
        const bf16_t* zt = Z + row0 * LDZ + h * 128;
        stage_tile64x128(Qp, zt + ZFF, c.tid); stage_tile64x128(Qp + 64 * QP, zt + ZFB, c.tid); stage_tile64x128(Kp, zt + ZQ, c.tid); stage_vt(Vt, zt + ZI, c.tid);
        __syncthreads();
        float gl[32], ky[32], qv[32];
        {
            const bf16_t* zr = Qp + (dir * 64 + half * 32) * QP + k; const bf16_t* qr = Kp + (half * 32) * QP + k;
#pragma unroll
            for (int i = 0; i < 32; ++i) { gl[i] = bf2f(zr[i * QP]); qv[i] = bf2f(qr[i * QP]); }
        }
        const float run = gate_cumsum(gl, ky, dir);
        __syncthreads();
        const float rsub = (half == dir) ? run : 0.f;
        bf16_t* qpd = Qp + (dir * 64 + half * 32) * QP + k; bf16_t* kpd = Kp + (dir * 64 + half * 32) * QP + k;
#pragma unroll
        for (int i = 0; i < 32; ++i) {
            const float e = __expf(gl[i] - rsub);
            qpd[i * QP] = f2bf(qv[i] * e);
            kpd[i * QP] = f2bf(ky[i] * __builtin_amdgcn_rcpf(e));
        }
    }
    const int fr = c.lane & 15, fq = c.lane >> 4;
    const int tt = c.wave & 3, vh = c.wave >> 2;
    bf16x8 sf[2][4][4];
#pragma unroll
    for (int dir = 0; dir < 2; ++dir) {
        const bf16_t* Sg = Lg + ((size_t)((dir * 16 + b * 4 + h) * 128 + (dir ? 127 - ch : ch))) * 16384;
#pragma unroll
        for (int vt = 0; vt < 4; ++vt)
#pragma unroll
            for (int ks = 0; ks < 4; ++ks) sf[dir][vt][ks] = *(const bf16x8*)(Sg + (size_t)((vh * 4 + vt) * 16 + fr) * 128 + fq * 8 + ks * 32);
    }
    bf16_t* grow = Z + (row0 + tt * 16 + fr) * LDZ + ZG + h * 128;
    u32x2 gwv[4];
#pragma unroll
    for (int vt = 0; vt < 4; ++vt) gwv[vt] = *(const u32x2*)(grow + (vh * 4 + vt) * 16 + fq * 4);
    __syncthreads();
    f32x4 acc[4];
#pragma unroll
    for (int vt = 0; vt < 4; ++vt) acc[vt] = (f32x4){0.f, 0.f, 0.f, 0.f};
#pragma unroll
    for (int dir = 0; dir < 2; ++dir) {
        bf16x8 qf[4];
#pragma unroll
        for (int ks = 0; ks < 4; ++ks) qf[ks] = *(const bf16x8*)(Qp + (size_t)(dir * 64 + tt * 16 + fr) * QP + ks * 32 + fq * 8);
        f32x4 at[4];
#pragma unroll
        for (int st = 0; st < 4; ++st) {
            f32x4 a = (f32x4){0.f, 0.f, 0.f, 0.f};
            const bf16_t* kr = Kp + (size_t)(dir * 64 + st * 16 + fr) * QP + fq * 8;
#pragma unroll
            for (int ks = 0; ks < 4; ++ks) a = __builtin_amdgcn_mfma_f32_16x16x32_bf16(*(const bf16x8*)(kr + ks * 32), qf[ks], a, 0, 0, 0);
#pragma unroll
            for (int j = 0; j < 4; ++j) { const int s = st * 16 + fq * 4 + j, t = tt * 16 + fr; const bool ok = dir ? (s >= t) : (s <= t); a[j] = ok ? a[j] : 0.f; }
            at[st] = a;
        }
#pragma unroll
        for (int kk = 0; kk < 2; ++kk) {
            u32x4 pw; pw.x = cvt_pk_bf16(at[2 * kk][0], at[2 * kk][1]); pw.y = cvt_pk_bf16(at[2 * kk][2], at[2 * kk][3]); pw.z = cvt_pk_bf16(at[2 * kk + 1][0], at[2 * kk + 1][1]); pw.w = cvt_pk_bf16(at[2 * kk + 1][2], at[2 * kk + 1][3]);
            const bf16x8 pf = __builtin_bit_cast(bf16x8, pw);
#pragma unroll
            for (int vt = 0; vt < 4; ++vt) {
                const int vx = ((((vh * 4 + vt) * 16 + fr) >> 3) & 7) << 3, vc = (2 * kk) * 16 + fq * 4; const bf16_t* vrow = Vt + (size_t)((vh * 4 + vt) * 16 + fr) * SP;
                u32x4 vw; const u32x2 v0 = *(const u32x2*)(vrow + (vc ^ vx)), v1 = *(const u32x2*)(vrow + ((vc + 16) ^ vx)); vw.x = v0.x; vw.y = v0.y; vw.z = v1.x; vw.w = v1.y;
                acc[vt] = __builtin_amdgcn_mfma_f32_16x16x32_bf16(__builtin_bit_cast(bf16x8, vw), pf, acc[vt], 0, 0, 0);
            }
        }
        if (A_MASK & 2) {
#pragma unroll
        for (int vt = 0; vt < 4; ++vt)
#pragma unroll
            for (int ks = 0; ks < 4; ++ks) acc[vt] = __builtin_amdgcn_mfma_f32_16x16x32_bf16(sf[dir][vt][ks], qf[ks], acc[vt], 0, 0, 0);
        }
    }
    float ss = 0.f;
#pragma unroll
    for (int vt = 0; vt < 4; ++vt) ss += (acc[vt][0] * acc[vt][0] + acc[vt][1] * acc[vt][1]) + (acc[vt][2] * acc[vt][2] + acc[vt][3] * acc[vt][3]);
    ss += __shfl_xor(ss, 16); ss += __shfl_xor(ss, 32);
    if (fq == 0) red[vh * 64 + tt * 16 + fr] = ss;
    __syncthreads();
    const float rstd = rsqrtf((red[tt * 16 + fr] + red[64 + tt * 16 + fr]) * (1.f / 128.f) + EPS);
#pragma unroll
    for (int vt = 0; vt < 4; ++vt) {
        const int v0 = (vh * 4 + vt) * 16 + fq * 4;
        const u32x2 gw = gwv[vt];
        const f32x4 nw = *(const f32x4*)(a_norm + v0);
        const float g0 = bf_lo(gw.x), g1 = bf_hi(gw.x), g2 = bf_lo(gw.y), g3 = bf_hi(gw.y);
        u32x2 o;
        o.x = cvt_pk_bf16(acc[vt][0] * rstd * nw[0] * g0 * sigmoidf_(g0), acc[vt][1] * rstd * nw[1] * g1 * sigmoidf_(g1));
        o.y = cvt_pk_bf16(acc[vt][2] * rstd * nw[2] * g2 * sigmoidf_(g2), acc[vt][3] * rstd * nw[3] * g3 * sigmoidf_(g3));
        *(u32x2*)(grow + v0 + (ocol - ZG)) = o;
    }
    __syncthreads();
}

__device__ __forceinline__ void p3_issue_raw(unsigned char* lds_raw_, const bf16_t* Z, int unit, int tid, int wave, u32x4 (&vreg)[2]) {
    constexpr int RAWB = 91136;
    const int ch = unit & 127, h = (unit >> 7) & 3, b = unit >> 9;
    const bf16_t* zt = Z + ((size_t)b * SEQ + (size_t)ch * 64) * LDZ + h * 128;
    LAS unsigned char* l3 = (LAS unsigned char*)lds_raw_ + RAWB;
#pragma unroll
    for (int i = 0; i < 2; ++i) { const int chunk = tid + 512 * i; const bf16_t* p = zt + (size_t)(chunk >> 4) * LDZ + (chunk & 15) * 8;
        __builtin_amdgcn_global_load_lds((const unsigned*)(p + ZFF), (LAS unsigned*)(l3 + 0 * 16384 + i * 8192 + wave * 1024), 16, 0, 0);
        __builtin_amdgcn_global_load_lds((const unsigned*)(p + ZFB), (LAS unsigned*)(l3 + 1 * 16384 + i * 8192 + wave * 1024), 16, 0, 0);
        __builtin_amdgcn_global_load_lds((const unsigned*)(p + ZQ),  (LAS unsigned*)(l3 + 2 * 16384 + i * 8192 + wave * 1024), 16, 0, 0);
        vreg[i] = *(const u32x4*)(p + ZI); }
}
#define LDS_BAR() do { asm volatile("s_waitcnt lgkmcnt(0)" ::: "memory"); __builtin_amdgcn_s_barrier(); asm volatile("" ::: "memory"); } while (0)
__device__ __forceinline__ void hgrn_pass3_phase(unsigned char* lds_raw_, bf16_t* Z, const float* a_norm, const bf16_t* Lg, int bid, int G, int ocol) {
    constexpr int QP = 136, SP = 72, RAWB = 91136;
    bf16_t* Qp = (bf16_t*)lds_raw_;
    bf16_t* Kp = Qp + 2 * 64 * QP;
    bf16_t* Vt = Kp + 2 * 64 * QP;
    float* red = (float*)(Vt + 128 * SP) + 512;
    const bf16_t* Raw = (const bf16_t*)(lds_raw_ + RAWB);
    u32x4 vreg[2];
    { const Ctx c0 = make_ctx(lds_raw_); if (bid < 2048) p3_issue_raw(lds_raw_, Z, bid, c0.tid, c0.wave, vreg); }
#pragma unroll 1
    for (int unit = bid; unit < 2048; unit += G) {
        const Ctx c = make_ctx(lds_raw_);
        const int ch = unit & 127, h = (unit >> 7) & 3, b = unit >> 9;
        const size_t row0 = (size_t)b * SEQ + (size_t)ch * 64;
#pragma unroll
        for (int i = 0; i < 2; ++i) { const int chunk = c.tid + 512 * i; const int s = chunk >> 4, part = chunk & 15;
            const u32x4 vv = vreg[i]; bf16_t* vd = Vt + (part * 8) * SP + (s ^ ((part & 7) << 3));
            vd[0 * SP] = (bf16_t)(vv.x & 0xffffu); vd[1 * SP] = (bf16_t)(vv.x >> 16); vd[2 * SP] = (bf16_t)(vv.y & 0xffffu); vd[3 * SP] = (bf16_t)(vv.y >> 16);
            vd[4 * SP] = (bf16_t)(vv.z & 0xffffu); vd[5 * SP] = (bf16_t)(vv.z >> 16); vd[6 * SP] = (bf16_t)(vv.w & 0xffffu); vd[7 * SP] = (bf16_t)(vv.w >> 16); }
        asm volatile("s_waitcnt vmcnt(0)" ::: "memory");
        __syncthreads();
        {
            const int dir = c.tid >> 8, half = (c.tid >> 7) & 1, k = c.tid & 127;
            float gl[32], ky[32], qv[32];
            {
                const bf16_t* zr = Raw + (dir * 64 + half * 32) * 128 + k; const bf16_t* qr = Raw + (128 + half * 32) * 128 + k;
#pragma unroll
                for (int i = 0; i < 32; ++i) { gl[i] = bf2f(zr[i * 128]); qv[i] = bf2f(qr[i * 128]); }
            }
            const float run = gate_cumsum(gl, ky, dir);
            const float rsub = (half == dir) ? run : 0.f;
            bf16_t* qpd = Qp + (dir * 64 + half * 32) * QP + k; bf16_t* kpd = Kp + (dir * 64 + half * 32) * QP + k;
#pragma unroll
            for (int i = 0; i < 32; ++i) {
                const float e = __expf(gl[i] - rsub);
                qpd[i * QP] = f2bf(qv[i] * e);
                kpd[i * QP] = f2bf(ky[i] * __builtin_amdgcn_rcpf(e));
            }
        }
        const int fr = c.lane & 15, fq = c.lane >> 4;
        const int tt = c.wave & 3, vh = c.wave >> 2;
        bf16x8 sf[2][4][4];
#pragma unroll
        for (int dir = 0; dir < 2; ++dir) {
            const bf16_t* Sg = Lg + ((size_t)((dir * 16 + b * 4 + h) * 128 + (dir ? 127 - ch : ch))) * 16384;
#pragma unroll
            for (int vt = 0; vt < 4; ++vt)
#pragma unroll
                for (int ks = 0; ks < 4; ++ks) sf[dir][vt][ks] = *(const bf16x8*)(Sg + (size_t)((vh * 4 + vt) * 16 + fr) * 128 + fq * 8 + ks * 32);
        }
        bf16_t* grow = Z + (row0 + tt * 16 + fr) * LDZ + ZG + h * 128;
        u32x2 gwv[4];
#pragma unroll
        for (int vt = 0; vt < 4; ++vt) gwv[vt] = *(const u32x2*)(grow + (vh * 4 + vt) * 16 + fq * 4);
        LDS_BAR();
        if (unit + G < 2048) p3_issue_raw(lds_raw_, Z, unit + G, c.tid, c.wave, vreg);
        f32x4 acc[4];
#pragma unroll
        for (int vt = 0; vt < 4; ++vt) acc[vt] = (f32x4){0.f, 0.f, 0.f, 0.f};
#pragma unroll
        for (int dir = 0; dir < 2; ++dir) {
            bf16x8 qf[4];
#pragma unroll
            for (int ks = 0; ks < 4; ++ks) qf[ks] = *(const bf16x8*)(Qp + (size_t)(dir * 64 + tt * 16 + fr) * QP + ks * 32 + fq * 8);
            f32x4 at[4];
#pragma unroll
            for (int st = 0; st < 4; ++st) {
                f32x4 a = (f32x4){0.f, 0.f, 0.f, 0.f};
                const bf16_t* kr = Kp + (size_t)(dir * 64 + st * 16 + fr) * QP + fq * 8;
#pragma unroll
                for (int ks = 0; ks < 4; ++ks) a = __builtin_amdgcn_mfma_f32_16x16x32_bf16(*(const bf16x8*)(kr + ks * 32), qf[ks], a, 0, 0, 0);
#pragma unroll
                for (int j = 0; j < 4; ++j) { const int s = st * 16 + fq * 4 + j, t = tt * 16 + fr; const bool ok = dir ? (s >= t) : (s <= t); a[j] = ok ? a[j] : 0.f; }
                at[st] = a;
            }
#pragma unroll
            for (int kk = 0; kk < 2; ++kk) {
                u32x4 pw; pw.x = cvt_pk_bf16(at[2 * kk][0], at[2 * kk][1]); pw.y = cvt_pk_bf16(at[2 * kk][2], at[2 * kk][3]); pw.z = cvt_pk_bf16(at[2 * kk + 1][0], at[2 * kk + 1][1]); pw.w = cvt_pk_bf16(at[2 * kk + 1][2], at[2 * kk + 1][3]);
                const bf16x8 pf = __builtin_bit_cast(bf16x8, pw);
#pragma unroll
                for (int vt = 0; vt < 4; ++vt) {
                    const int vx = ((((vh * 4 + vt) * 16 + fr) >> 3) & 7) << 3, vc = (2 * kk) * 16 + fq * 4; const bf16_t* vrow = Vt + (size_t)((vh * 4 + vt) * 16 + fr) * SP;
                    u32x4 vw; const u32x2 v0 = *(const u32x2*)(vrow + (vc ^ vx)), v1 = *(const u32x2*)(vrow + ((vc + 16) ^ vx)); vw.x = v0.x; vw.y = v0.y; vw.z = v1.x; vw.w = v1.y;
                    acc[vt] = __builtin_amdgcn_mfma_f32_16x16x32_bf16(__builtin_bit_cast(bf16x8, vw), pf, acc[vt], 0, 0, 0);
                }
            }
            if (A_MASK & 2) {
#pragma unroll
            for (int vt = 0; vt < 4; ++vt)
#pragma unroll
                for (int ks = 0; ks < 4; ++ks) acc[vt] = __builtin_amdgcn_mfma_f32_16x16x32_bf16(sf[dir][vt][ks], qf[ks], acc[vt], 0, 0, 0);
            }
        }
        float ss = 0.f;
#pragma unroll
        for (int vt = 0; vt < 4; ++vt) ss += (acc[vt][0] * acc[vt][0] + acc[vt][1] * acc[vt][1]) + (acc[vt][2] * acc[vt][2] + acc[vt][3] * acc[vt][3]);
        ss += __shfl_xor(ss, 16); ss += __shfl_xor(ss, 32);
        if (fq == 0) red[vh * 64 + tt * 16 + fr] = ss;
        LDS_BAR();
        const float rstd = rsqrtf((red[tt * 16 + fr] + red[64 + tt * 16 + fr]) * (1.f / 128.f) + EPS);
#pragma unroll
        for (int vt = 0; vt < 4; ++vt) {
            const int v0 = (vh * 4 + vt) * 16 + fq * 4;
            const u32x2 gw = gwv[vt];
            const f32x4 nw = *(const f32x4*)(a_norm + v0);
            const float g0 = bf_lo(gw.x), g1 = bf_hi(gw.x), g2 = bf_lo(gw.y), g3 = bf_hi(gw.y);
            u32x2 o;
            o.x = cvt_pk_bf16(acc[vt][0] * rstd * nw[0] * g0 * sigmoidf_(g0), acc[vt][1] * rstd * nw[1] * g1 * sigmoidf_(g1));
            o.y = cvt_pk_bf16(acc[vt][2] * rstd * nw[2] * g2 * sigmoidf_(g2), acc[vt][3] * rstd * nw[3] * g3 * sigmoidf_(g3));
            *(u32x2*)(grow + v0 + (ocol - ZG)) = o;
        }
        LDS_BAR();
    }
}

#define XB_TMO      128
#define XB_XCNT(j)  (256  + 64 * (j))
#define XB_XSUB(j)  (1280 + 64 * (j))
#define XB_XGEN(j)  (2304 + 64 * (j))
#define XB_TOP      3328
#define XB_TOPGEN   3392
#define XCD_BAR_WORDS 3456
#define XB_SPIN_CAP (1u << 20)
constexpr size_t WS_BAR = 896 * 1024;
constexpr int LDS_MISC_OFF = LDS_BYTES - 64;
__device__ __forceinline__ unsigned xb_ld(unsigned* p)              { return __hip_atomic_load(p, __ATOMIC_RELAXED, __HIP_MEMORY_SCOPE_AGENT); }
__device__ __forceinline__ unsigned xb_add(unsigned* p, unsigned v) { return __hip_atomic_fetch_add(p, v, __ATOMIC_RELAXED, __HIP_MEMORY_SCOPE_AGENT); }
__device__ __forceinline__ unsigned xb_xcc_id() { return (unsigned)__builtin_amdgcn_s_getreg((3 << 11) | 20) & 0xFu; }
#define XB_SPIN(cond, bar) do { unsigned _sp = 0; while (cond) { __builtin_amdgcn_s_sleep(1); \
    if ((++_sp & 255u) == 0u) { if (xb_ld(&(bar)[XB_TMO])) break; if (_sp > XB_SPIN_CAP) { atomicAdd(&(bar)[XB_TMO], 1u); break; } } } } while (0)
struct XcdBarrier { unsigned* bar; unsigned x; volatile LAS unsigned* st; };
__device__ __forceinline__ XcdBarrier xcd_barrier_post(unsigned* bar, volatile LAS unsigned* st) {
    XcdBarrier b; b.bar = bar; b.x = xb_xcc_id(); b.st = st;
    if (threadIdx.x == 0) (void)xb_add(&bar[XB_XCNT(b.x)], 1u);
    return b;
}
__device__ __forceinline__ void xcd_barrier_complete(unsigned* bar, unsigned x, unsigned& nloc, unsigned& nx) {
    const unsigned G = gridDim.x * gridDim.y * gridDim.z;
    unsigned sum, cnt, mine, sp = 0u;
    for (;;) {
        sum = 0u; cnt = 0u; mine = 0u;
#pragma unroll
        for (unsigned j = 0; j < 16; ++j) { const unsigned c = xb_ld(&bar[XB_XCNT(j)]); sum += c; cnt += (c > 0u) ? 1u : 0u; mine = (j == x) ? c : mine; }
        if (sum == G) break;
        __builtin_amdgcn_s_sleep(1);
        if ((++sp & 255u) == 0u) { if (xb_ld(&bar[XB_TMO])) break; if (sp > XB_SPIN_CAP) { atomicAdd(&bar[XB_TMO], 1u); break; } }
    }
    nloc = mine > 0u ? mine : 1u; nx = cnt > 0u ? cnt : 1u;
}
__device__ __forceinline__ void xcd_barrier(const XcdBarrier& b) {
    asm volatile("s_waitcnt vmcnt(0)" ::: "memory");
    __syncthreads();
    if (threadIdx.x == 0) {
        unsigned* bar = b.bar;
        __builtin_amdgcn_s_waitcnt(0);
        unsigned nloc = b.st[0], nx = b.st[1];
        if (nloc == 0u) { xcd_barrier_complete(bar, b.x, nloc, nx); b.st[0] = nloc; b.st[1] = nx; }
        const unsigned old = xb_add(&bar[XB_XSUB(b.x)], 1u);
        const unsigned gen = old / nloc;
        if (old + 1u == (gen + 1u) * nloc) {
            __builtin_amdgcn_fence(__ATOMIC_RELEASE, "agent");
            asm volatile("s_waitcnt vmcnt(0)" ::: "memory");
            const unsigned og = xb_add(&bar[XB_TOP], 1u);
            const unsigned tg = og / nx;
            if (og + 1u == (tg + 1u) * nx) xb_add(&bar[XB_TOPGEN], 1u);
            else XB_SPIN(xb_ld(&bar[XB_TOPGEN]) == tg, bar);
            __builtin_amdgcn_fence(__ATOMIC_ACQUIRE, "agent");
            xb_add(&bar[XB_XGEN(b.x)], 1u);
            asm volatile("s_waitcnt vmcnt(0)" ::: "memory");
        } else {
            XB_SPIN(xb_ld(&bar[XB_XGEN(b.x)]) == gen, bar);
            __builtin_amdgcn_fence(__ATOMIC_ACQUIRE, "agent");
            asm volatile("s_waitcnt vmcnt(0)" ::: "memory");
        }
    }
    __syncthreads();
}

struct Args { const float* in[14]; float* out; unsigned char* ws; int ph_lo, ph_hi; };
typedef __attribute__((address_space(4))) const unsigned long long* kargp_t;
__device__ __forceinline__ kargp_t kargs_now() { kargp_t p = (kargp_t)__builtin_amdgcn_kernarg_segment_ptr(); asm volatile("" : "+s"(p)); return p; }
#define GAS1 __attribute__((address_space(1)))
#define KIN(i) ((const float*)(const GAS1 float*)ka[i])
#define KOUT ((float*)(GAS1 float*)ka[14])
#define KWS ((unsigned char*)(GAS1 unsigned char*)ka[15])

__global__ void __launch_bounds__(512, 2) fwd_megakernel(Args a) {
    extern __shared__ __attribute__((aligned(16))) unsigned char lds_raw[];
    LAS unsigned char* ldsl = (LAS unsigned char*)lds_raw;
    const int ph_lo = a.ph_lo, ph_hi = a.ph_hi;
    XcdBarrier xbar; xbar.bar = (unsigned*)(a.ws + WS_BAR); xbar.x = 0; xbar.st = (volatile LAS unsigned*)(ldsl + LDS_MISC_OFF);
    if (USE_XB) {
        if (threadIdx.x < 16) ((LAS unsigned*)(ldsl + LDS_MISC_OFF))[threadIdx.x] = 0u;
        if (blockIdx.x == 0) for (int i = threadIdx.x; i < 4096; i += 512) ((unsigned*)(a.ws + WS_BAR))[i] = 0u;
        __syncthreads();
    }
    for (int ph = ph_lo; ph < ph_hi; ++ph) {
        if (ph > ph_lo) { if (USE_XB && ph > ph_lo + 1) { xcd_barrier(xbar); } else { cg::this_grid().sync(); if (USE_XB) xbar = xcd_barrier_post((unsigned*)(a.ws + WS_BAR), (volatile LAS unsigned*)(ldsl + LDS_MISC_OFF)); } }
        const Ctx c = make_ctx(lds_raw);
        const kargp_t ka = kargs_now();
        unsigned char* ws = KWS;
        bf16_t* Z = (bf16_t*)(ws + WS_Z);
        bf16_t* Wb = (bf16_t*)(ws + WS_W);
        bf16_t* Lg = (bf16_t*)(ws + WS_L);
        float* DEC = (float*)(ws + WS_DEC);
        if (ph == NPH - 1) { if (PHON(10)) rms_rows_f32_inplace(c, KOUT, KIN(13)); continue; }
        const int nrep = DUP_THIN ? 2 : 1;
        const int l = ph / 9, k9 = ph % 9; const int k = k9 < 7 ? k9 : k9 + 1;
        if (k == 0 && PHON(0)) {
            for (int rep = 0; rep < nrep; ++rep) phase_pre(c, l, KIN(1), KIN(2), KIN(3), KIN(5), KIN(8), KIN(9), KIN(10), KIN(11), KIN(12), l == 0 ? KIN(0) : KOUT, ws);
            __syncthreads();
        } else if (k == 1 && PHON(1)) {
            pg8::Gemm g{Z + ZXN, (const bf16_t*)((const char*)Wb + W_IN), T, NZ, D, LDZ}; pg8::StaticOrder S; S.init(T, NZ, c.G, c.bid);
            pg8::EpiZ E{Z, LDZ, (const float*)(ws + WS_LOW), (const f32x2*)(ws + WS_ROPE)};
            if (DUP_GEMM) pg8::gemm_phase<pg8::EpiZ>(ldsl, g, S, E, c.tid);
            pg8::gemm_phase<pg8::EpiZ>(ldsl, g, S, E, c.tid);
        } else if (k == 2 && PHON(2)) {
            const float* lbl = KIN(3);
            const int nmine = (512 + 256 + 2048 - c.bid + c.G - 1) / c.G;
            for (int kq = 0; kq < nmine; ++kq) {
                const int u = c.bid + ((c.bid & 1) ? (nmine - 1 - kq) : kq) * c.G;
                const Ctx c = make_ctx(lds_raw);
                if (u < 512) { if (BR_MASK & 1) branch_c_unit(c, Z, KIN(7) + l * 8, u); }
                else if (u < 768) { if (BR_MASK & 2) branch_b_unit(c, Z, (const bf16_t*)(ws + WS_WSB), KIN(6) + (size_t)l * 512, u - 512); }
                else if (BR_MASK & 4) { if (DUP_P1) hgrn_pass1_unit(c, Z, Lg, DEC, (float*)(ws + WS_ENR), u - 768); hgrn_pass1_unit(c, Z, Lg, DEC, (float*)(ws + WS_ENR), u - 768); }
            }
        } else if (k == 3 && PHON(3)) {
            hgrn_scan(c, Lg, DEC, (const float*)(ws + WS_ENR));
        } else if (k == 4 && PHON(4)) {
            hgrn_pass3_phase(lds_raw, Z, KIN(4) + (size_t)l * 128, Lg, c.bid, c.G, ZG);
        } else if (k == 5 && PHON(5)) {
            bf16_t* Mg = (bf16_t*)(ws + WS_MERGED); bf16_t* Sg = (bf16_t*)(ws + WS_SST);
            pg8::StaticOrder S; S.init(T, D, c.G, c.bid);
#pragma unroll 1
            for (int rep = 0; rep < 1 + DUP_GEMM; ++rep)
#pragma unroll 1
            for (int b = 0; b < 3; ++b) {
                pg8::Gemm gg{Z + ZXN, (const bf16_t*)((const char*)Wb + W_IN) + (size_t)(NZ + b * D) * D, T, D, D, LDZ};
                pg8::EpiAct<0> Eg{b == 0 ? Mg : Sg, D, nullptr};
                { const Ctx c2 = make_ctx(lds_raw); pg8::gemm_phase<pg8::EpiAct<0>>(ldsl, gg, S, Eg, c2.tid); }
                const int ycol = b == 0 ? ZG : (b == 1 ? ZU : ZCQ);
                pg8::Gemm gp{Z + ycol, (const bf16_t*)((const char*)Wb + W_BR) + (size_t)b * D * 512, T, D, 512, LDZ};
                const Ctx c3 = make_ctx(lds_raw);
                if (b == 0) { pg8::EpiMul<0> Em{Mg, Sg, D}; pg8::gemm_phase<pg8::EpiMul<0>>(ldsl, gp, S, Em, c3.tid); }
                else { pg8::EpiMul<1> Em{Mg, Sg, D}; pg8::gemm_phase<pg8::EpiMul<1>>(ldsl, gp, S, Em, c3.tid); }
            }
        } else if (k == 6 && PHON(6)) {
            pg8::Gemm g{(const bf16_t*)(ws + WS_MERGED), (const bf16_t*)((const char*)Wb + W_OUT), T, D, D, D}; pg8::StaticOrder S; S.init(T, D, c.G, c.bid);
            pg8::EpiRes<true> E{l == 0 ? KIN(0) : KOUT, KOUT, D, (bf16_t*)(ws + WS_SST), (float*)(ws + WS_SUMSQ)};
            pg8::gemm_phase<pg8::EpiRes<true>>(ldsl, g, S, E, c.tid);
        } else if (k == 7 && PHON(7)) {
            for (int rep = 0; rep < nrep; ++rep) rms_rows_bf16(c, KOUT, KIN(10) + (size_t)l * D, (bf16_t*)(ws + WS_HN), D);
        } else if (k == 8 && PHON(8)) {
            pg8::Gemm g{(const bf16_t*)(ws + WS_SST), (const bf16_t*)((const char*)Wb + W_UP), T, DFF, D, D}; pg8::StaticOrder S; S.init(T, DFF, c.G, c.bid);
            pg8::EpiAct<1> E{Z, DFF, (const float*)(ws + WS_SUMSQ)};
            pg8::gemm_phase<pg8::EpiAct<1>>(ldsl, g, S, E, c.tid);
        } else if (k == 9 && PHON(9)) {
            pg8::Gemm g{Z, (const bf16_t*)((const char*)Wb + W_DN), T, D, DFF, DFF}; pg8::StaticOrder S; S.init(T, D, c.G, c.bid);
            pg8::EpiRes<false> E{KOUT, KOUT, D, nullptr, nullptr};
            pg8::gemm_phase<pg8::EpiRes<false>>(ldsl, g, S, E, c.tid);
        }
    }
}

extern "C" void kernel_launch(void* const* d_in, const int* in_sizes, int n_in, void* d_out, int out_size, void* d_ws, size_t ws_size, hipStream_t stream) {
    static int grid = 0;
    if (grid == 0) {
        if (n_in != 14 || out_size != T * D || ws_size < WS_END) { fprintf(stderr, "kernel_launch: unexpected shapes (n_in %d out %d ws %zu)\n", n_in, out_size, ws_size); grid = -1; return; }
        int dev = 0, cus = 0, per_cu = 0;
        hipGetDevice(&dev); hipDeviceGetAttribute(&cus, hipDeviceAttributeMultiprocessorCount, dev);
        if (hipFuncSetAttribute((const void*)fwd_megakernel, hipFuncAttributeMaxDynamicSharedMemorySize, LDS_BYTES) != hipSuccess) { fprintf(stderr, "kernel_launch: hipFuncSetAttribute failed\n"); grid = -1; return; }
        if (hipOccupancyMaxActiveBlocksPerMultiprocessor(&per_cu, (const void*)fwd_megakernel, 512, LDS_BYTES) != hipSuccess || per_cu < 1) { fprintf(stderr, "kernel_launch: occupancy query says %d\n", per_cu); per_cu = 1; }
        (void)hipGetLastError();
        grid = cus * 1;
    }
    if (grid < 0) return;
    Args a{};
    for (int i = 0; i < 14; ++i) a.in[i] = (const float*)d_in[i];
    a.out = (float*)d_out; a.ws = (unsigned char*)d_ws;
#if MK_ONE_LAUNCH
    a.ph_lo = 0; a.ph_hi = NPH;
    void* args[] = {&a};
    hipError_t e = hipLaunchCooperativeKernel((const void*)fwd_megakernel, dim3(grid), dim3(512), args, LDS_BYTES, stream);
    if (e != hipSuccess) fprintf(stderr, "cooperative launch failed: %s (grid %d)\n", hipGetErrorString(e), grid);
#else
    for (int ph = 0; ph < NPH; ++ph) {
        a.ph_lo = ph; a.ph_hi = ph + 1;
        hipLaunchKernelGGL(fwd_megakernel, dim3(grid), dim3(512), LDS_BYTES, stream, a);
    }
#endif
}
```

```cpp
#include <hip/hip_runtime.h>
#include <hip/hip_cooperative_groups.h>
#include <cstdio>
#include <cstdint>
namespace cg = cooperative_groups;

#ifndef PH_MASK
#define PH_MASK 0x7ff
#endif
#ifndef BR_MASK
#define BR_MASK 7
#endif
#ifndef A_MASK
#define A_MASK 3
#endif
#ifndef TPROBE_A
#define TPROBE_A -1
#endif
#ifndef TPROBE_B
#define TPROBE_B -1
#endif
#ifndef DUP_GEMM
#define DUP_GEMM 0
#endif
#ifndef DUP_SYNC
#define DUP_SYNC 0
#endif
#ifndef DUP_THIN
#define DUP_THIN 0
#endif
#ifndef USE_XB
#define USE_XB 1
#endif
#ifndef DUP_P1
#define DUP_P1 0
#endif
#ifndef DUP_P3
#define DUP_P3 0
#endif
#ifndef DUP_C
#define DUP_C 0
#endif
#define PHON(n) ((PH_MASK >> (n)) & 1)
#ifndef MK_ONE_LAUNCH
#define MK_ONE_LAUNCH 1
#endif

#define LAS __attribute__((address_space(3)))
typedef unsigned short bf16_t;
typedef short bf16x8 __attribute__((ext_vector_type(8)));
typedef float f32x4 __attribute__((ext_vector_type(4)));
typedef float f32x2 __attribute__((ext_vector_type(2)));
typedef unsigned u32x4 __attribute__((ext_vector_type(4)));
typedef unsigned u32x2 __attribute__((ext_vector_type(2)));

constexpr int T = 32768, SEQ = 8192, D = 1024, DFF = 4096, DIN = 7424, NZ = 4352, LDZ = 5376, DEPTH = 2;
constexpr int ZQ = 0, ZI = 512, ZFF = 1024, ZFB = 1536, ZG = 2048, ZU = 2560, ZV = 3072, ZCQ = 3584, ZCK = 4096, ZCV = 4224, ZXN = 4352;
constexpr float EPS = 1e-6f;
constexpr size_t MiB = 1u << 20;
constexpr size_t WS_ROPE = 0;
constexpr size_t WS_WSB = 1 * MiB;
constexpr size_t WS_LOW = 640 * 1024;
constexpr size_t WS_ETN = 1 * MiB + 256 * 1024;
constexpr size_t WS_SUMSQ = 1 * MiB + 512 * 1024;
constexpr size_t WS_DEC = 2 * MiB;
constexpr size_t WS_W = 4 * MiB;
constexpr size_t W_IN = 0, W_BR = (size_t)DIN * D * 2, W_OUT = W_BR + (size_t)3 * D * 512 * 2, W_UP = W_OUT + (size_t)D * D * 2, W_DN = W_UP + (size_t)DFF * D * 2;
constexpr size_t WS_Z = 40 * MiB;
constexpr size_t WS_L = 376 * MiB;
constexpr size_t WS_MERGED = WS_L, WS_SST = WS_L + 64 * MiB, WS_HN = WS_L;
constexpr size_t WS_ENR = 504 * MiB;
constexpr size_t WS_END = 506 * MiB;
constexpr int LDS_BYTES = 147456;
constexpr int NPH = 9 * DEPTH + 1;

typedef __bf16 bf16v2_t __attribute__((ext_vector_type(2)));
__device__ __forceinline__ unsigned cvt_pk_bf16(float lo, float hi) { const f32x2 v = {lo, hi}; const bf16v2_t b = __builtin_convertvector(v, bf16v2_t); return __builtin_bit_cast(unsigned, b); }
__device__ __forceinline__ float bf_lo(unsigned w) { return __uint_as_float(w << 16); }
__device__ __forceinline__ float bf_hi(unsigned w) { return __uint_as_float(w & 0xffff0000u); }
__device__ __forceinline__ float bf2f(bf16_t b) { return __uint_as_float(((unsigned)b) << 16); }
__device__ __forceinline__ bf16_t f2bf(float f) { return (bf16_t)(cvt_pk_bf16(f, 0.f) & 0xffffu); }
__device__ __forceinline__ float wave_sum(float v) {
#pragma unroll
    for (int o = 1; o < 64; o <<= 1) v += __shfl_xor(v, o);
    return v;
}
__device__ __forceinline__ float gelu_tanh(float x) { const float u = 1.5957691216f * (x + 0.044715f * x * x * x); return x * __builtin_amdgcn_rcpf(1.0f + __expf(-u)); }
__device__ __forceinline__ float sigmoidf_(float x) { return __builtin_amdgcn_rcpf(1.0f + __expf(-x)); }

namespace pg8 {
constexpr int BM = 256, BK = 64, HALF = 128, HTB = HALF * BK * 2, STAGE_BYTES = 8 * HTB, NXCD = 8, WGM = 8;
__host__ __device__ __forceinline__ int lds_byte(int r, int c) { const int st = (r >> 4) * 2 + (c >> 5), rr = r & 15, cc = c & 31, ob = rr * 64 + cc * 2; return st * 1024 + (ob ^ (((ob >> 9) & 1) << 5)); }
__host__ __device__ __forceinline__ void stage_rc(int b, int& R, int& C) { const int st = b / 1024, sb = b % 1024, swz = sb ^ (((sb >> 9) & 1) << 5); R = (st >> 1) * 16 + swz / 64; C = (st & 1) * 32 + (swz % 64) / 2; }
__host__ __device__ __forceinline__ int perm32(int rho) { const int n = rho >> 4, i = rho & 15; return 8 * (i >> 2) + 4 * n + (i & 3); }

struct Unit { int pm, pn; };
struct Gemm { const bf16_t* A; const bf16_t* Bt; int M, N, K, lda; };

struct StaticOrder {
    int nM, nN, nwg, G, c;
    __device__ void init(int M, int N, int G_, int c_) { nM = M / BM; nN = N / BM; nwg = nM * nN; G = G_; c = c_; }
    __device__ bool next(int i, Unit& u) const {
        const long L = (long)i * G + c; if (L >= nwg) return false;
        int wgid = (int)L; { const int q = nwg / NXCD, r = nwg % NXCD, xcd = wgid % NXCD, off = wgid / NXCD; wgid = (xcd < r ? xcd * (q + 1) : r * (q + 1) + (xcd - r) * q) + off; }
        const int nig = WGM * nN, gid = wgid / nig, fm = gid * WGM, gsz = (nM - fm) < WGM ? (nM - fm) : WGM;
        u.pm = fm + ((wgid % nig) % gsz); u.pn = (wgid % nig) / gsz; return true;
    }
};

typedef const f32x4 (&AccRef)[2][2][4][2];

struct EpiZ {
    static constexpr bool PERM = true;
    bf16_t* O; int ldc; const float* low; const f32x2* rope;
    __device__ __forceinline__ void operator()(AccRef acc, const Unit& u, int wr, int wc, int fr, int fq) const {
        const int row0 = u.pm * BM + wr * 64 + fr, col0 = u.pn * BM + wc * 32 + 8 * fq;
        const int mode = (u.pn >= 10 && u.pn < 14) ? 1 : ((u.pn >= 4 && u.pn < 8) ? 2 : (u.pn >= 14 ? 3 : 0));
        const bool rlane = ((wc & 1) == 0) && (fq < 2);
#pragma unroll
        for (int bj = 0; bj < 2; ++bj) {
            f32x4 l0 = (f32x4){0.f, 0.f, 0.f, 0.f}, l1 = l0;
            if (mode == 2) { const float* lp = low + (col0 + bj * HALF - 1024); l0 = *(const f32x4*)lp; l1 = *(const f32x4*)(lp + 4); }
#pragma unroll
            for (int ai = 0; ai < 2; ++ai)
#pragma unroll
                for (int m = 0; m < 4; ++m) { bf16_t* rowp = O + (size_t)(row0 + ai * HALF + m * 16) * ldc + col0;
                    f32x4 v0 = acc[ai][bj][m][0], v1 = acc[ai][bj][m][1];
                    if (mode == 1) {
#pragma unroll
                        for (int j = 0; j < 4; ++j) { v0[j] = gelu_tanh(v0[j]); v1[j] = gelu_tanh(v1[j]); }
                    } else if (mode == 2) {
#pragma unroll
                        for (int j = 0; j < 4; ++j) { v0[j] = __logf(l0[j] + (1.0f - l0[j]) * sigmoidf_(v0[j])); v1[j] = __logf(l1[j] + (1.0f - l1[j]) * sigmoidf_(v1[j])); }
                    } else if (mode == 3 && (u.pn < 16 || bj == 0)) {
                        f32x4 p0, p1;
#pragma unroll
                        for (int j = 0; j < 4; ++j) { p0[j] = __shfl_xor(v0[j], 16); p1[j] = __shfl_xor(v1[j], 16); }
                        if (rlane) {
                            const int pos = (row0 + ai * HALF + m * 16) & (SEQ - 1);
                            const f32x4* rp = (const f32x4*)(rope + (size_t)pos * 8);
                            const f32x4 r0 = rp[0], r1 = rp[1], r2 = rp[2], r3 = rp[3];
                            const float sg = fq == 0 ? -1.f : 1.f;
                            v0[0] = v0[0] * r0.x + sg * p0[0] * r0.y; v0[1] = v0[1] * r0.z + sg * p0[1] * r0.w; v0[2] = v0[2] * r1.x + sg * p0[2] * r1.y; v0[3] = v0[3] * r1.z + sg * p0[3] * r1.w;
                            v1[0] = v1[0] * r2.x + sg * p1[0] * r2.y; v1[1] = v1[1] * r2.z + sg * p1[1] * r2.w; v1[2] = v1[2] * r3.x + sg * p1[2] * r3.y; v1[3] = v1[3] * r3.z + sg * p1[3] * r3.w;
                        }
                    }
                    u32x4 w; w.x = cvt_pk_bf16(v0[0], v0[1]); w.y = cvt_pk_bf16(v0[2], v0[3]); w.z = cvt_pk_bf16(v1[0], v1[1]); w.w = cvt_pk_bf16(v1[2], v1[3]);
                    *(u32x4*)(rowp + bj * HALF) = w; }
        }
    }
};
template <int ACT  > struct EpiAct {
    static constexpr bool PERM = true;
    bf16_t* O; int ldc; const float* sumsq;
    __device__ __forceinline__ void operator()(AccRef acc, const Unit& u, int wr, int wc, int fr, int fq) const {
        const int row0 = u.pm * BM + wr * 64 + fr, col0 = u.pn * BM + wc * 32 + 8 * fq;
#pragma unroll
        for (int ai = 0; ai < 2; ++ai)
#pragma unroll
            for (int m = 0; m < 4; ++m) { bf16_t* rowp = O + (size_t)(row0 + ai * HALF + m * 16) * ldc + col0;
                float r2 = 1.f; if (ACT == 1) r2 = __builtin_amdgcn_rcpf(sumsq[row0 + ai * HALF + m * 16] * (1.f / D) + EPS);
#pragma unroll
                for (int bj = 0; bj < 2; ++bj) { f32x4 v0 = acc[ai][bj][m][0], v1 = acc[ai][bj][m][1];
#pragma unroll
                    for (int j = 0; j < 4; ++j) {
                        if (ACT == 0) { v0[j] = sigmoidf_(v0[j]); v1[j] = sigmoidf_(v1[j]); }
                        else { const float a = fmaxf(v0[j], 0.f), b = fmaxf(v1[j], 0.f); v0[j] = a * a * r2; v1[j] = b * b * r2; } }
                    u32x4 w; w.x = cvt_pk_bf16(v0[0], v0[1]); w.y = cvt_pk_bf16(v0[2], v0[3]); w.z = cvt_pk_bf16(v1[0], v1[1]); w.w = cvt_pk_bf16(v1[2], v1[3]);
                    *(u32x4*)(rowp + bj * HALF) = w; } }
    }
};
template <int MODE  > struct EpiMul {
    static constexpr bool PERM = true;
    bf16_t* Mg; const bf16_t* Sg; int ldc;
    __device__ __forceinline__ void operator()(AccRef acc, const Unit& u, int wr, int wc, int fr, int fq) const {
        const int row0 = u.pm * BM + wr * 64 + fr, col0 = u.pn * BM + wc * 32 + 8 * fq;
#pragma unroll
        for (int ai = 0; ai < 2; ++ai)
#pragma unroll
            for (int m = 0; m < 4; ++m) { const size_t off = (size_t)(row0 + ai * HALF + m * 16) * ldc + col0;
#pragma unroll
                for (int bj = 0; bj < 2; ++bj) { const f32x4 v0 = acc[ai][bj][m][0], v1 = acc[ai][bj][m][1];
                    const u32x4 mw = *(const u32x4*)(Mg + off + bj * HALF);
                    u32x4 w;
                    if (MODE == 0) {
                        w.x = cvt_pk_bf16(bf_lo(mw.x) * v0[0], bf_hi(mw.x) * v0[1]); w.y = cvt_pk_bf16(bf_lo(mw.y) * v0[2], bf_hi(mw.y) * v0[3]);
                        w.z = cvt_pk_bf16(bf_lo(mw.z) * v1[0], bf_hi(mw.z) * v1[1]); w.w = cvt_pk_bf16(bf_lo(mw.w) * v1[2], bf_hi(mw.w) * v1[3]);
                    } else {
                        const u32x4 sw = *(const u32x4*)(Sg + off + bj * HALF);
                        w.x = cvt_pk_bf16(bf_lo(mw.x) + bf_lo(sw.x) * v0[0], bf_hi(mw.x) + bf_hi(sw.x) * v0[1]); w.y = cvt_pk_bf16(bf_lo(mw.y) + bf_lo(sw.y) * v0[2], bf_hi(mw.y) + bf_hi(sw.y) * v0[3]);
                        w.z = cvt_pk_bf16(bf_lo(mw.z) + bf_lo(sw.z) * v1[0], bf_hi(mw.z) + bf_hi(sw.z) * v1[1]); w.w = cvt_pk_bf16(bf_lo(mw.w) + bf_lo(sw.w) * v1[2], bf_hi(mw.w) + bf_hi(sw.w) * v1[3]);
                    }
                    *(u32x4*)(Mg + off + bj * HALF) = w; }
                if (m & 1) asm volatile("" ::: "memory"); }
    }
};
template <bool SQ> struct EpiRes {
    static constexpr bool PERM = false;
    const float* base; float* out; int ldc; bf16_t* xb; float* sumsq;
    __device__ __forceinline__ void operator()(AccRef acc, const Unit& u, int wr, int wc, int fr, int fq) const {
        const int row0 = u.pm * BM + wr * 64 + fr, col0 = u.pn * BM + wc * 32 + 4 * fq;
#pragma unroll
        for (int ai = 0; ai < 2; ++ai)
#pragma unroll
            for (int m = 0; m < 4; ++m) { const int row = row0 + ai * HALF + m * 16; const size_t off = (size_t)row * ldc + col0; float ss = 0.f;
#pragma unroll
                for (int bj = 0; bj < 2; ++bj)
#pragma unroll
                    for (int n = 0; n < 2; ++n) {
                        if (SQ) { const f32x4 b = *(const f32x4*)(base + off + bj * HALF + n * 16); const f32x4 v = b + acc[ai][bj][m][n];
                            ss += (v[0] * v[0] + v[1] * v[1]) + (v[2] * v[2] + v[3] * v[3]); u32x2 w; w.x = cvt_pk_bf16(v[0], v[1]); w.y = cvt_pk_bf16(v[2], v[3]); *(u32x2*)(xb + off + bj * HALF + n * 16) = w; }
                        else { const u32x2 bw = *(const u32x2*)(xb + off + bj * HALF + n * 16); const f32x4 a4 = acc[ai][bj][m][n];
                            f32x4 v; v[0] = bf_lo(bw.x) + a4[0]; v[1] = bf_hi(bw.x) + a4[1]; v[2] = bf_lo(bw.y) + a4[2]; v[3] = bf_hi(bw.y) + a4[3]; *(f32x4*)(out + off + bj * HALF + n * 16) = v; } }
                if (SQ) { ss += __shfl_xor(ss, 16); ss += __shfl_xor(ss, 32); if (fq == 0) __hip_atomic_fetch_add(sumsq + row, ss, __ATOMIC_RELAXED, __HIP_MEMORY_SCOPE_AGENT); }
                if (m & 1) asm volatile("" ::: "memory"); }
    }
};

template <class Epi>
__device__ __forceinline__ void gemm_phase(LAS unsigned char* lds, const Gemm g, const StaticOrder& S, const Epi& E, const int tid) {
    const int wid = __builtin_amdgcn_readfirstlane(tid >> 6), lane = tid & 63, wr = wid >> 2, wc = wid & 3, fr = lane & 15, fq = lane >> 4;
    const int K = g.K, nt = K / BK;
    unsigned voffA[2], voffB[2];
#pragma unroll
    for (int i = 0; i < 2; ++i) { int R, C; stage_rc(tid * 16 + i * 8192, R, C); const int Rb = Epi::PERM ? ((R & ~31) + perm32(R & 31)) : R;
        voffA[i] = (unsigned)(R * g.lda + C) * 2u; voffB[i] = (unsigned)(Rb * K + C) * 2u; }
    const size_t kstep = (size_t)(BK * 2);
    const size_t hstepA = (size_t)HALF * g.lda * 2, hstepB = (size_t)HALF * K * 2;
    const size_t tstepA = 2 * hstepA, tstepB = 2 * hstepB;
    const unsigned ldsw = (unsigned)wid * 1024u;
    const int aoff = lds_byte(wr * 64 + fr, fq * 8), boff = lds_byte(wc * 32 + fr, fq * 8);
#define PG8_SA(b, h) (((b) * 2 + (h)) * HTB)
#define PG8_SB(b, h) ((4 + (b) * 2 + (h)) * HTB)
#define PG8_STAGE(bufoff, gbase, voff) do { _Pragma("unroll") for (int _i = 0; _i < 2; ++_i) \
        __builtin_amdgcn_global_load_lds((const unsigned*)((const char*)(gbase) + (voff)[_i]), (LAS unsigned*)(lds + (bufoff) + ldsw + _i * 8192), 16, 0, 0); } while (0)
#define PG8_LDA(dst, b, h) do { _Pragma("unroll") for (int m = 0; m < 4; ++m) _Pragma("unroll") for (int k = 0; k < 2; ++k) dst[m][k] = *(const LAS bf16x8*)(lds + PG8_SA(b, h) + aoff + m * 2048 + k * 1024); } while (0)
#define PG8_LDB(dst, b, h) do { _Pragma("unroll") for (int n = 0; n < 2; ++n) _Pragma("unroll") for (int k = 0; k < 2; ++k) dst[n][k] = *(const LAS bf16x8*)(lds + PG8_SB(b, h) + boff + n * 2048 + k * 1024); } while (0)
#define PG8_MMA(ai, bj, At, Bt) do { __builtin_amdgcn_s_setprio(1); _Pragma("unroll") for (int m = 0; m < 4; ++m) _Pragma("unroll") for (int n = 0; n < 2; ++n) _Pragma("unroll") for (int k = 0; k < 2; ++k) \
        acc[ai][bj][m][n] = __builtin_amdgcn_mfma_f32_16x16x32_bf16(Bt[n][k], At[m][k], acc[ai][bj][m][n], 0, 0, 0); __builtin_amdgcn_s_setprio(0); } while (0)
#define PG8_WAIT_V(n) asm volatile("s_waitcnt vmcnt(" #n ")" ::: "memory")
#define PG8_WAIT_L(n) asm volatile("s_waitcnt lgkmcnt(" #n ")" ::: "memory")
#define PG8_BAR __builtin_amdgcn_s_barrier()
#define PG8_SCHED __builtin_amdgcn_sched_barrier(0)
    Unit cur, nxt; int ui = 0;
    if (!S.next(0, cur)) return;
    f32x4 acc[2][2][4][2];
#pragma unroll
    for (int a = 0; a < 2; ++a)
#pragma unroll
        for (int b = 0; b < 2; ++b)
#pragma unroll
            for (int m = 0; m < 4; ++m)
#pragma unroll
                for (int n = 0; n < 2; ++n) acc[a][b][m][n] = (f32x4){0.f, 0.f, 0.f, 0.f};
    bf16x8 At[4][2], B0[2][2], B1[2][2];
    const char* cA = (const char*)g.A + (size_t)cur.pm * tstepA; const char* cB = (const char*)g.Bt + (size_t)cur.pn * tstepB;
    PG8_STAGE(PG8_SB(0, 0), cB, voffB); PG8_STAGE(PG8_SB(0, 1), cB + hstepB, voffB); PG8_STAGE(PG8_SA(0, 0), cA, voffA); PG8_STAGE(PG8_SA(0, 1), cA + hstepA, voffA);
    if (wr == 1) PG8_BAR;
    PG8_WAIT_V(2); PG8_BAR;
    PG8_STAGE(PG8_SB(1, 0), cB + kstep, voffB); PG8_STAGE(PG8_SA(1, 0), cA + kstep, voffA); PG8_STAGE(PG8_SB(1, 1), cB + hstepB + kstep, voffB);
    PG8_WAIT_V(6); PG8_BAR;
    for (;;) {
        const bool has_next = S.next(ui + 1, nxt);
        const char* nA = has_next ? (const char*)g.A + (size_t)nxt.pm * tstepA : cA; const char* nB = has_next ? (const char*)g.Bt + (size_t)nxt.pn * tstepB : cB;
        for (int t = 0; t < nt; t += 2) {
            const bool last = (t == nt - 2);
            const char* a1 = cA + (size_t)(t + 1) * kstep;
            const char* a2 = last ? nA : cA + (size_t)(t + 2) * kstep; const char* b2 = last ? nB : cB + (size_t)(t + 2) * kstep;
            const char* a3 = a2 + kstep; const char* b3 = b2 + kstep;
            PG8_LDB(B0, 0, 0); PG8_LDB(B1, 0, 1); PG8_SCHED; PG8_LDA(At, 0, 0); PG8_STAGE(PG8_SA(1, 1), a1 + hstepA, voffA);
            PG8_WAIT_V(8); PG8_WAIT_L(0); PG8_BAR; PG8_MMA(0, 0, At, B0); PG8_MMA(0, 1, At, B1); PG8_BAR; PG8_SCHED;
            PG8_LDA(At, 0, 1); PG8_STAGE(PG8_SB(0, 0), b2, voffB); PG8_STAGE(PG8_SB(0, 1), b2 + hstepB, voffB); PG8_STAGE(PG8_SA(0, 0), a2, voffA);
            PG8_WAIT_V(8); PG8_WAIT_L(0); PG8_BAR; PG8_MMA(1, 0, At, B0); PG8_MMA(1, 1, At, B1); PG8_BAR; PG8_SCHED;
            PG8_LDB(B0, 1, 0); PG8_LDB(B1, 1, 1); PG8_SCHED; PG8_LDA(At, 1, 0); PG8_STAGE(PG8_SA(0, 1), a2 + hstepA, voffA);
            PG8_WAIT_V(8); PG8_WAIT_L(0); PG8_BAR; PG8_MMA(0, 0, At, B0); PG8_MMA(0, 1, At, B1); PG8_BAR; PG8_SCHED;
            PG8_LDA(At, 1, 1); PG8_STAGE(PG8_SB(1, 0), b3, voffB); PG8_STAGE(PG8_SB(1, 1), b3 + hstepB, voffB); PG8_STAGE(PG8_SA(1, 0), a3, voffA);
            PG8_WAIT_V(8); PG8_WAIT_L(0); PG8_BAR; PG8_MMA(1, 0, At, B0); PG8_MMA(1, 1, At, B1); PG8_BAR; PG8_SCHED;
        }
        if (wr == 0) PG8_BAR;
        E(acc, cur, wr, wc, fr, fq);
        if (!has_next) break;
#pragma unroll
        for (int a = 0; a < 2; ++a)
#pragma unroll
            for (int b = 0; b < 2; ++b)
#pragma unroll
                for (int m = 0; m < 4; ++m)
#pragma unroll
                    for (int n = 0; n < 2; ++n) acc[a][b][m][n] = (f32x4){0.f, 0.f, 0.f, 0.f};
        cur = nxt; cA = nA; cB = nB; ++ui;
        if (wr == 1) PG8_BAR;
    }
    PG8_WAIT_V(0);
    PG8_BAR;
#undef PG8_SA
#undef PG8_SB
#undef PG8_STAGE
#undef PG8_LDA
#undef PG8_LDB
#undef PG8_MMA
#undef PG8_WAIT_V
#undef PG8_WAIT_L
#undef PG8_BAR
#undef PG8_SCHED
}
}

struct Ctx { unsigned char* lds; int tid, lane, wave, bid, G; };
__device__ __forceinline__ Ctx make_ctx(unsigned char* lds) { int tid = threadIdx.x; asm volatile("" : "+v"(tid)); Ctx c; c.lds = lds; c.tid = tid; c.lane = tid & 63; c.wave = __builtin_amdgcn_readfirstlane(tid >> 6); c.bid = blockIdx.x; c.G = gridDim.x; return c; }

__device__ __forceinline__ void transpose_item(const float* W, int K, int N, bf16_t* WT, float* scr, int item, int lane, const float* kscale = nullptr) {
    const int nblk = N / 32, kb = item / nblk, nb = item % nblk, k0 = 64 * kb, n0 = 32 * nb;
#pragma unroll 8
    for (int i = 0; i < 32; ++i) { const int kk = 2 * i + (lane >> 5); scr[kk * 33 + (lane & 31)] = W[(size_t)(k0 + kk) * N + n0 + (lane & 31)] * (kscale ? kscale[k0 + kk] : 1.f); }
    asm volatile("s_waitcnt lgkmcnt(0)" ::: "memory");
    const int c = lane & 7;
#pragma unroll
    for (int j = 0; j < 4; ++j) { const int n = (lane >> 3) + 8 * j; const float* s = scr + (8 * c) * 33 + n;
        u32x4 o; o.x = cvt_pk_bf16(s[0 * 33], s[1 * 33]); o.y = cvt_pk_bf16(s[2 * 33], s[3 * 33]); o.z = cvt_pk_bf16(s[4 * 33], s[5 * 33]); o.w = cvt_pk_bf16(s[6 * 33], s[7 * 33]);
        *(u32x4*)(WT + (size_t)(n0 + n) * K + k0 + 8 * c) = o; }
    asm volatile("s_waitcnt lgkmcnt(0)" ::: "memory");
}

__device__ __forceinline__ void rms_rows_bf16(const Ctx& c, const float* src, const float* w, bf16_t* dst, int ldo) {
    const int gw = c.bid * 8 + c.wave, NGW = c.G * 8;
    f32x4 wv[4];
#pragma unroll
    for (int j = 0; j < 4; ++j) wv[j] = *((const f32x4*)w + c.lane + 64 * j);
    for (int m = gw; m < T; m += NGW) {
        const f32x4* xr = (const f32x4*)(src + (size_t)m * D) + c.lane;
        f32x4 v[4]; float s = 0.f;
#pragma unroll
        for (int j = 0; j < 4; ++j) { v[j] = xr[64 * j]; s += (v[j].x * v[j].x + v[j].y * v[j].y) + (v[j].z * v[j].z + v[j].w * v[j].w); }
        const float rstd = rsqrtf(wave_sum(s) * (1.f / D) + EPS);
        u32x2* o8 = (u32x2*)(dst + (size_t)m * ldo) + c.lane;
#pragma unroll
        for (int j = 0; j < 4; ++j) { u32x2 o; o.x = cvt_pk_bf16(v[j].x * rstd * wv[j].x, v[j].y * rstd * wv[j].y); o.y = cvt_pk_bf16(v[j].z * rstd * wv[j].z, v[j].w * rstd * wv[j].w); o8[64 * j] = o; }
    }
}
__device__ __forceinline__ void rms_rows_f32_inplace(const Ctx& c, float* x, const float* w) {
    const int gw = c.bid * 8 + c.wave, NGW = c.G * 8;
    f32x4 wv[4];
#pragma unroll
    for (int j = 0; j < 4; ++j) wv[j] = *((const f32x4*)w + c.lane + 64 * j);
    for (int m = gw; m < T; m += NGW) {
        f32x4* xr = (f32x4*)(x + (size_t)m * D) + c.lane;
        f32x4 v[4]; float s = 0.f;
#pragma unroll
        for (int j = 0; j < 4; ++j) { v[j] = xr[64 * j]; s += (v[j].x * v[j].x + v[j].y * v[j].y) + (v[j].z * v[j].z + v[j].w * v[j].w); }
        const float rstd = rsqrtf(wave_sum(s) * (1.f / D) + EPS);
#pragma unroll
        for (int j = 0; j < 4; ++j) xr[64 * j] = v[j] * rstd * wv[j];
    }
}

__device__ __forceinline__ float lower_bound_of(const float* lb_logits, int l, int dir, int col) {
    if (l == 0) return 0.f;
    const float l0 = lb_logits[dir * 512 + col], l1 = lb_logits[1024 + dir * 512 + col];
    return 1.0f / (1.0f + __expf(l0 - l1));
}

__device__ __forceinline__ void phase_pre(const Ctx& c, int l, const float* in1, const float* in2, const float* in3, const float* in5, const float* in8, const float* in9, const float* in10, const float* in11, const float* in12, const float* xsrc, unsigned char* ws) {
    float* scr = (float*)(c.lds + c.wave * 8704);
    const int gw = c.bid * 8 + c.wave, NGW = c.G * 8;
    bf16_t* Wb = (bf16_t*)(ws + WS_W);
    const float* w_in = in1 + (size_t)l * D * DIN; const float* w_br = in8 + (size_t)l * 3 * 512 * D; const float* w_out = in9 + (size_t)l * D * D;
    const float* w_up = in11 + (size_t)l * D * DFF; const float* w_dn = in12 + (size_t)l * DFF * D;
    constexpr int I_IN = (D / 64) * (DIN / 32), I_BR = (512 / 64) * (D / 32), I_OUT = (D / 64) * (D / 32), I_UP = (D / 64) * (DFF / 32), I_DN = (DFF / 64) * (D / 32);
    constexpr int NITEMS = I_IN + 3 * I_BR + I_OUT + I_UP + I_DN;
    for (int it = gw; it < NITEMS; it += NGW) {
        int r = it;
        if (r < I_IN) { transpose_item(w_in, D, DIN, (bf16_t*)((char*)Wb + W_IN), scr, r, c.lane); continue; } r -= I_IN;
        if (r < 3 * I_BR) { const int b = r / I_BR; transpose_item(w_br + (size_t)b * 512 * D, 512, D, (bf16_t*)((char*)Wb + W_BR) + (size_t)b * D * 512, scr, r % I_BR, c.lane); continue; } r -= 3 * I_BR;
        if (r < I_OUT) { transpose_item(w_out, D, D, (bf16_t*)((char*)Wb + W_OUT), scr, r, c.lane); continue; } r -= I_OUT;
        if (r < I_UP) { transpose_item(w_up, D, DFF, (bf16_t*)((char*)Wb + W_UP), scr, r, c.lane, in10 + (size_t)l * D); continue; } r -= I_UP;
        transpose_item(w_dn, DFF, D, (bf16_t*)((char*)Wb + W_DN), scr, r, c.lane);
    }
    const int gt = c.bid * 512 + c.tid, NGT = c.G * 512;
    {
        const float* wsrc = in5 + (size_t)l * 4 * 128 * 128; bf16_t* wd = (bf16_t*)(ws + WS_WSB);
        for (int i = gt; i < 4 * 128 * 128; i += NGT) wd[i] = f2bf(wsrc[i]);
    }
    {   float* sq = (float*)(ws + WS_SUMSQ); for (int i = gt; i < T; i += NGT) sq[i] = 0.f; }
    {
        float* low = (float*)(ws + WS_LOW);
        for (int i = gt; i < 1024; i += NGT) low[i] = lower_bound_of(in3, l, i >> 9, i & 511);
    }
    if (l == 0) {
        f32x2* rt = (f32x2*)(ws + WS_ROPE);
        for (int i = gt; i < SEQ * 8; i += NGT) {
            const int pos = i >> 3, j = i & 7;
            const float inv = j == 0 ? 1.0f : j == 1 ? 0.1939227432012558f : j == 2 ? 0.03760603070259094f : j == 3 ? 0.007292664609849453f : j == 4 ? 0.0014142135623842478f : j == 5 ? 0.00027424818836152554f : j == 6 ? 5.318296098266728e-05f : 1.0313386155758053e-05f;
            const float ang = (float)pos * inv;
            const double rev = (double)ang * 0.15915494309189535; const double fr = rev - __builtin_rint(rev);
            const float f = (float)fr;
            rt[i] = (f32x2){__builtin_amdgcn_cosf(f), __builtin_amdgcn_sinf(f)};
        }
    }
    rms_rows_bf16(c, xsrc, in2 + (size_t)l * D, (bf16_t*)(ws + WS_Z) + ZXN, LDZ);
}

__device__ __forceinline__ void branch_b_unit(const Ctx& c, bf16_t* Z, const bf16_t* WSB, const float* bs, int unit) {
    constexpr int VP = 136;
    bf16_t* vnT = (bf16_t*)c.lds;
    bf16_t* zrow0 = Z + (size_t)unit * 128 * LDZ;
    const int fr = c.lane & 15, fq = c.lane >> 4;
    {
        const int p = c.wave * 16 + fr;
        const bf16_t* src = zrow0 + (size_t)p * LDZ + ZV + fq * 128;
        u32x4 raw[16]; float s = 0.f;
#pragma unroll
        for (int i = 0; i < 16; ++i) { raw[i] = *(const u32x4*)(src + i * 8);
            s += (bf_lo(raw[i].x) + bf_hi(raw[i].x)) + (bf_lo(raw[i].y) + bf_hi(raw[i].y)) + (bf_lo(raw[i].z) + bf_hi(raw[i].z)) + (bf_lo(raw[i].w) + bf_hi(raw[i].w)); }
        s += __shfl_xor(s, 16); s += __shfl_xor(s, 32);
        const float mean = s * (1.f / 512.f); float q = 0.f;
#pragma unroll
        for (int i = 0; i < 16; ++i) {
            float d;
            d = bf_lo(raw[i].x) - mean; q += d * d; d = bf_hi(raw[i].x) - mean; q += d * d; d = bf_lo(raw[i].y) - mean; q += d * d; d = bf_hi(raw[i].y) - mean; q += d * d;
            d = bf_lo(raw[i].z) - mean; q += d * d; d = bf_hi(raw[i].z) - mean; q += d * d; d = bf_lo(raw[i].w) - mean; q += d * d; d = bf_hi(raw[i].w) - mean; q += d * d; }
        q += __shfl_xor(q, 16); q += __shfl_xor(q, 32);
        const float rstd = rsqrtf(q * (1.f / 512.f) + EPS);
        bf16_t* dst = vnT + (size_t)(fq * 128) * VP + p;
#pragma unroll
        for (int i = 0; i < 16; ++i) {
            dst[(i * 8 + 0) * VP] = f2bf((bf_lo(raw[i].x) - mean) * rstd); dst[(i * 8 + 1) * VP] = f2bf((bf_hi(raw[i].x) - mean) * rstd);
            dst[(i * 8 + 2) * VP] = f2bf((bf_lo(raw[i].y) - mean) * rstd); dst[(i * 8 + 3) * VP] = f2bf((bf_hi(raw[i].y) - mean) * rstd);
            dst[(i * 8 + 4) * VP] = f2bf((bf_lo(raw[i].z) - mean) * rstd); dst[(i * 8 + 5) * VP] = f2bf((bf_hi(raw[i].z) - mean) * rstd);
            dst[(i * 8 + 6) * VP] = f2bf((bf_lo(raw[i].w) - mean) * rstd); dst[(i * 8 + 7) * VP] = f2bf((bf_hi(raw[i].w) - mean) * rstd); }
    }
    __syncthreads();
    const int q = c.wave * 16 + fr;
#pragma unroll 1
    for (int g = 0; g < 4; ++g) {
        bf16x8 wf[4];
#pragma unroll
        for (int kk = 0; kk < 4; ++kk) wf[kk] = *(const bf16x8*)(WSB + (size_t)(g * 128 + q) * 128 + kk * 32 + fq * 8);
        const float bias = bs[g * 128 + q];
        bf16_t* ub = zrow0 + (size_t)q * LDZ + ZU + g * 128 + fq * 4;
        u32x2 uu[8];
#pragma unroll
        for (int ct = 0; ct < 8; ++ct) uu[ct] = *(const u32x2*)(ub + ct * 16);
#pragma unroll
        for (int ct = 0; ct < 8; ++ct) {
            f32x4 acc = (f32x4){0.f, 0.f, 0.f, 0.f};
#pragma unroll
            for (int kk = 0; kk < 4; ++kk) { const bf16x8 a = *(const bf16x8*)(vnT + (size_t)(g * 128 + ct * 16 + fr) * VP + kk * 32 + fq * 8); acc = __builtin_amdgcn_mfma_f32_16x16x32_bf16(a, wf[kk], acc, 0, 0, 0); }
            u32x2 o; o.x = cvt_pk_bf16(bf_lo(uu[ct].x) * (acc[0] + bias), bf_hi(uu[ct].x) * (acc[1] + bias)); o.y = cvt_pk_bf16(bf_lo(uu[ct].y) * (acc[2] + bias), bf_hi(uu[ct].y) * (acc[3] + bias));
            *(u32x2*)(ub + ct * 16) = o;
        }
    }
    __syncthreads();
}

__device__ __forceinline__ void branch_c_unit(const Ctx& c, bf16_t* Z, const float* sink, int unit) {
    constexpr int KP = 72, VTP = 408;
    bf16_t* Ks = (bf16_t*)c.lds;
    bf16_t* Vt = (bf16_t*)(c.lds + 400 * KP * 2);
    const int hk = unit & 1, n = (unit >> 1) & 63, b = unit >> 7;
    const int fr = c.lane & 15, fq = c.lane >> 4;
    const size_t rowb = (size_t)b * SEQ;
    const int g = c.wave >> 1, half = c.wave & 1, head = hk * 4 + g;
    bf16_t* qrow0 = Z + (rowb + n * 128 + half * 64 + fr) * LDZ + ZCQ + head * 64;
    u32x4 qa[4], qb[4];
#pragma unroll
    for (int qt = 0; qt < 4; ++qt) { qa[qt] = *(const u32x4*)(qrow0 + (size_t)qt * 16 * LDZ + fq * 8); qb[qt] = *(const u32x4*)(qrow0 + (size_t)qt * 16 * LDZ + 32 + fq * 8); }
    {
        u32x4 kv[7], vv[7];
#pragma unroll
        for (int it = 0; it < 7; ++it) {
            const int chunk = c.tid + 512 * it; const int row = chunk >> 3, part = chunk & 7;
            const int tk = (n - 1) * 128 + row;
            const bool valid = row < 384 && tk >= 0 && tk < SEQ;
            kv[it] = (u32x4){0u, 0u, 0u, 0u}; vv[it] = (u32x4){0u, 0u, 0u, 0u};
            if (valid) { const bf16_t* zr = Z + (rowb + tk) * LDZ; kv[it] = *(const u32x4*)(zr + ZCK + hk * 64 + part * 8); vv[it] = *(const u32x4*)(zr + ZCV + hk * 64 + part * 8); }
        }
#pragma unroll
        for (int it = 0; it < 7; ++it) {
            const int chunk = c.tid + 512 * it; const int row = chunk >> 3, part = chunk & 7;
            if (row < 400) {
                *(u32x4*)(Ks + row * KP + part * 8) = kv[it];
                bf16_t* vd = Vt + (part * 8) * VTP + row;
                vd[0 * VTP] = (bf16_t)(vv[it].x & 0xffffu); vd[1 * VTP] = (bf16_t)(vv[it].x >> 16); vd[2 * VTP] = (bf16_t)(vv[it].y & 0xffffu); vd[3 * VTP] = (bf16_t)(vv[it].y >> 16);
                vd[4 * VTP] = (bf16_t)(vv[it].z & 0xffffu); vd[5 * VTP] = (bf16_t)(vv[it].z >> 16); vd[6 * VTP] = (bf16_t)(vv[it].w & 0xffffu); vd[7 * VTP] = (bf16_t)(vv[it].w >> 16);
            }
        }
    }
    __syncthreads();
    const float sk = sink[head];
    const int base = fq * 4 - fr;
#pragma unroll
    for (int qt = 0; qt < 4; ++qt) {
        const int q0 = half * 64 + qt * 16;
        const bf16x8 qf0 = __builtin_bit_cast(bf16x8, qa[qt]), qf1 = __builtin_bit_cast(bf16x8, qb[qt]);
        const int kt0 = q0 >> 4;
        f32x4 s[17]; float mx = sk;
#pragma unroll
        for (int tt = 0; tt < 17; ++tt) {
            const int kt = kt0 + tt;
            const bool tile_ok = !((n == 0 && kt < 8) || (n == 63 && kt >= 16));
            f32x4 a = (f32x4){-1e30f, -1e30f, -1e30f, -1e30f};
            if (tile_ok) {
                const bf16_t* kr = Ks + (kt * 16 + fr) * KP + fq * 8;
                a = (f32x4){0.f, 0.f, 0.f, 0.f};
                a = __builtin_amdgcn_mfma_f32_16x16x32_bf16(*(const bf16x8*)kr, qf0, a, 0, 0, 0);
                a = __builtin_amdgcn_mfma_f32_16x16x32_bf16(*(const bf16x8*)(kr + 32), qf1, a, 0, 0, 0);
#pragma unroll
                for (int j = 0; j < 4; ++j) {
                    float v = a[j] * 0.125f;
                    if (tt == 0) v = (base + j >= 0) ? v : -1e30f;
                    if (tt == 16) v = (base + j <= 0) ? v : -1e30f;
                    a[j] = v; mx = fmaxf(mx, v);
                }
            }
            s[tt] = a;
        }
        mx = fmaxf(mx, __shfl_xor(mx, 16)); mx = fmaxf(mx, __shfl_xor(mx, 32));
        float lsum = 0.f;
#pragma unroll
        for (int tt = 0; tt < 17; ++tt)
#pragma unroll
            for (int j = 0; j < 4; ++j) { const float p = __expf(s[tt][j] - mx); s[tt][j] = p; lsum += p; }
        lsum += __shfl_xor(lsum, 16); lsum += __shfl_xor(lsum, 32);
        lsum += __expf(sk - mx);
        const float rl = __builtin_amdgcn_rcpf(lsum);
        f32x4 o[4];
#pragma unroll
        for (int dt = 0; dt < 4; ++dt) o[dt] = (f32x4){0.f, 0.f, 0.f, 0.f};
#pragma unroll
        for (int kk = 0; kk < 9; ++kk) {
            u32x4 pw; pw.x = cvt_pk_bf16(s[2 * kk][0], s[2 * kk][1]); pw.y = cvt_pk_bf16(s[2 * kk][2], s[2 * kk][3]);
            if (kk < 8) { pw.z = cvt_pk_bf16(s[2 * kk + 1][0], s[2 * kk + 1][1]); pw.w = cvt_pk_bf16(s[2 * kk + 1][2], s[2 * kk + 1][3]); } else { pw.z = 0u; pw.w = 0u; }
            const bf16x8 pf = __builtin_bit_cast(bf16x8, pw);
#pragma unroll
            for (int dt = 0; dt < 4; ++dt) {
                const bf16_t* vr = Vt + (dt * 16 + fr) * VTP + (kt0 + 2 * kk) * 16 + fq * 4;
                u32x4 vw; const u32x2 v0 = *(const u32x2*)vr, v1 = *(const u32x2*)(vr + 16); vw.x = v0.x; vw.y = v0.y; vw.z = v1.x; vw.w = v1.y;
                o[dt] = __builtin_amdgcn_mfma_f32_16x16x32_bf16(__builtin_bit_cast(bf16x8, vw), pf, o[dt], 0, 0, 0);
            }
        }
        bf16_t* qrow = qrow0 + (size_t)qt * 16 * LDZ;
#pragma unroll
        for (int dt = 0; dt < 4; ++dt) { u32x2 w; w.x = cvt_pk_bf16(o[dt][0] * rl, o[dt][1] * rl); w.y = cvt_pk_bf16(o[dt][2] * rl, o[dt][3] * rl); *(u32x2*)(qrow + dt * 16 + fq * 4) = w; }
    }
    __syncthreads();
}

__device__ __forceinline__ void stage_tile64x128(bf16_t* dst  , const bf16_t* src  , int tid) {
#pragma unroll
    for (int i = 0; i < 2; ++i) { const int chunk = tid + 512 * i; const int s = chunk >> 4, part = chunk & 15;
        *(u32x4*)(dst + s * 136 + part * 8) = *(const u32x4*)(src + (size_t)s * LDZ + part * 8); }
}
__device__ __forceinline__ void stage_vt(bf16_t* Vt  , const bf16_t* src, int tid) {
    constexpr int SP = 72;
#pragma unroll
    for (int i = 0; i < 2; ++i) { const int chunk = tid + 512 * i; const int s = chunk >> 4, part = chunk & 15;
        const u32x4 vv = *(const u32x4*)(src + (size_t)s * LDZ + part * 8);
        bf16_t* vd = Vt + (part * 8) * SP + (s ^ ((part & 7) << 3));
        vd[0 * SP] = (bf16_t)(vv.x & 0xffffu); vd[1 * SP] = (bf16_t)(vv.x >> 16); vd[2 * SP] = (bf16_t)(vv.y & 0xffffu); vd[3 * SP] = (bf16_t)(vv.y >> 16);
        vd[4 * SP] = (bf16_t)(vv.z & 0xffffu); vd[5 * SP] = (bf16_t)(vv.z >> 16); vd[6 * SP] = (bf16_t)(vv.w & 0xffffu); vd[7 * SP] = (bf16_t)(vv.w >> 16); }
}
__device__ __forceinline__ float gate_cumsum(float (&gl)[32], float (&ky)[32], int dir) {
#pragma unroll
    for (int i = 0; i < 32; ++i) ky[i] = 1.0f - __expf(gl[i]);
    float run = 0.f;
    if (dir == 0) {
#pragma unroll
        for (int i = 0; i < 32; ++i) { run += gl[i]; gl[i] = run; }
    } else {
#pragma unroll
        for (int i = 31; i >= 0; --i) { run += gl[i]; gl[i] = run; }
    }
    return run;
}
__device__ __forceinline__ void hgrn_pass1_unit(const Ctx& c, const bf16_t* Z, bf16_t* Lg, float* DEC, float* ENR, int unit) {
    constexpr int SP = 72, QP = 136;
    bf16_t* Raw = (bf16_t*)c.lds;
    bf16_t* KdT = (bf16_t*)c.lds;
    bf16_t* Vt = (bf16_t*)(c.lds + 2 * 128 * SP * 2);
    float* tot = (float*)(c.lds + 3 * 128 * SP * 2);
    const int ch = unit & 127, h = (unit >> 7) & 3, b = unit >> 9;
    const size_t row0 = (size_t)b * SEQ + (size_t)ch * 64;
    const int dir = c.tid >> 8, half = (c.tid >> 7) & 1, k = c.tid & 127;
    const bf16_t* zt = Z + row0 * LDZ + h * 128;
    stage_tile64x128(Raw, zt + ZFF, c.tid); stage_tile64x128(Raw + 64 * QP, zt + ZFB, c.tid); stage_vt(Vt, zt + ZI, c.tid);
    __syncthreads();
    float gl[32], ky[32];
    {
        const bf16_t* zr = Raw + (dir * 64 + half * 32) * QP + k;
#pragma unroll
        for (int i = 0; i < 32; ++i) gl[i] = bf2f(zr[i * QP]);
    }
    const float run = gate_cumsum(gl, ky, dir);
    tot[(dir * 2 + half) * 128 + k] = run;
    __syncthreads();
    const bool near = (half == dir);
    const float tother = tot[(dir * 2 + (half ^ 1)) * 128 + k];
    const float add = run + (near ? tother : 0.f);
    if (near) { const size_t di = ((size_t)((dir * 16 + b * 4 + h) * 128 + (dir ? 127 - ch : ch))) * 128 + k; DEC[di] = __expf(run + tother); ENR[di] = __expf(run); }
    {
        unsigned pkd[16];
#pragma unroll
        for (int i = 0; i < 32; i += 2) pkd[i >> 1] = cvt_pk_bf16(ky[i] * __expf(add - gl[i]), ky[i + 1] * __expf(add - gl[i + 1]));
        u32x4* dst = (u32x4*)(KdT + (dir * 128 + k) * SP + half * 32);
#pragma unroll
        for (int w = 0; w < 4; ++w) dst[w] = (u32x4){pkd[4 * w], pkd[4 * w + 1], pkd[4 * w + 2], pkd[4 * w + 3]};
    }
    __syncthreads();
    {
        const int fr = c.lane & 15, fq = c.lane >> 4;
        const int wd = c.wave >> 2, kq = c.wave & 3;
        bf16_t* Lo = Lg + ((size_t)((wd * 16 + b * 4 + h) * 128 + (wd ? 127 - ch : ch))) * 128 * 128;
#pragma unroll
        for (int kt = 0; kt < 2; ++kt) {
            const bf16_t* ar = KdT + (wd * 128 + kq * 32 + kt * 16 + fr) * SP + fq * 8;
            const bf16x8 a0 = *(const bf16x8*)ar, a1 = *(const bf16x8*)(ar + 32);
#pragma unroll
            for (int vt = 0; vt < 8; ++vt) {
                const int vx = (((vt * 16 + fr) >> 3) & 7) << 3;
                const bf16_t* br = Vt + (vt * 16 + fr) * SP;
                f32x4 acc = (f32x4){0.f, 0.f, 0.f, 0.f};
                acc = __builtin_amdgcn_mfma_f32_16x16x32_bf16(a0, *(const bf16x8*)(br + ((fq * 8) ^ vx)), acc, 0, 0, 0);
                acc = __builtin_amdgcn_mfma_f32_16x16x32_bf16(a1, *(const bf16x8*)(br + ((fq * 8 + 32) ^ vx)), acc, 0, 0, 0);
                u32x2 w; w.x = cvt_pk_bf16(acc[0], acc[1]); w.y = cvt_pk_bf16(acc[2], acc[3]);
                *(u32x2*)(Lo + (size_t)(vt * 16 + fr) * 128 + kq * 32 + kt * 16 + fq * 4) = w;
            }
        }
    }
    __syncthreads();
}

__device__ __forceinline__ void hgrn_scan(const Ctx& c, bf16_t* Lg, const float* DEC, const float* ENR) {
    for (int idx = c.bid * 512 + c.tid; idx < 32 * 128 * 32; idx += c.G * 512) {
        const int k4 = idx & 31, v = (idx >> 5) & 127, seq = idx >> 12;
        bf16_t* lp = Lg + (size_t)seq * 128 * 16384 + (size_t)v * 128 + k4 * 4;
        const float* dp = DEC + (size_t)seq * 128 * 128 + k4 * 4;
        const float* ep = ENR + (size_t)seq * 128 * 128 + k4 * 4;
        f32x4 st = (f32x4){0.f, 0.f, 0.f, 0.f};
#pragma unroll 1
        for (int c0 = 0; c0 < 128; c0 += 8) {
            u32x2 lw[8]; f32x4 dd[8], ee[8];
#pragma unroll
            for (int i = 0; i < 8; ++i) { lw[i] = *(const u32x2*)(lp + (size_t)(c0 + i) * 16384); dd[i] = *(const f32x4*)(dp + (size_t)(c0 + i) * 128); ee[i] = *(const f32x4*)(ep + (size_t)(c0 + i) * 128); }
#pragma unroll
            for (int i = 0; i < 8; ++i) {
                u32x2 o; o.x = cvt_pk_bf16(st[0] * ee[i][0], st[1] * ee[i][1]); o.y = cvt_pk_bf16(st[2] * ee[i][2], st[3] * ee[i][3]);
                *(u32x2*)(lp + (size_t)(c0 + i) * 16384) = o;
                st[0] = dd[i][0] * st[0] + bf_lo(lw[i].x); st[1] = dd[i][1] * st[1] + bf_hi(lw[i].x); st[2] = dd[i][2] * st[2] + bf_lo(lw[i].y); st[3] = dd[i][3] * st[3] + bf_hi(lw[i].y);
            }
        }
    }
}

__device__ __forceinline__ void hgrn_pass3_unit(const Ctx& c, bf16_t* Z, const float* a_norm, const bf16_t* Lg, int unit, int ocol) {
    constexpr int QP = 136, SP = 72;
    bf16_t* Qp = (bf16_t*)c.lds;
    bf16_t* Kp = Qp + 2 * 64 * QP;
    bf16_t* Vt = Kp + 2 * 64 * QP;
    float* tot = (float*)(Vt + 128 * SP);
    float* red = tot + 512;
    const int ch = unit & 127, h = (unit >> 7) & 3, b = unit >> 9;
    const size_t row0 = (size_t)b * SEQ + (size_t)ch * 64;
    {
        const int dir = c.tid >> 8, half = (c.tid >> 7) & 1, k = c.tid & 127;
        const bf16_t* zt = Z + row0 * LDZ + h * 128;
        stage_tile64x128(Qp, zt + ZFF, c.tid); stage_tile64x128(Qp + 64 * QP, zt + ZFB, c.tid); stage_tile64x128(Kp, zt + ZQ, c.tid); stage_vt(Vt, zt + ZI, c.tid);
        __syncthreads();
        float gl[32], ky[32], qv[32];
        {
            const bf16_t* zr = Qp + (dir * 64 + half * 32) * QP + k; const bf16_t* qr = Kp + (half * 32) * QP + k;
#pragma unroll
            for (int i = 0; i < 32; ++i) { gl[i] = bf2f(zr[i * QP]); qv[i] = bf2f(qr[i * QP]); }
        }
        const float run = gate_cumsum(gl, ky, dir);
        __syncthreads();
        const float rsub = (half == dir) ? run : 0.f;
        bf16_t* qpd = Qp + (dir * 64 + half * 32) * QP + k; bf16_t* kpd = Kp + (dir * 64 + half * 32) * QP + k;
#pragma unroll
        for (int i = 0; i < 32; ++i) {
            const float e = __expf(gl[i] - rsub);
            qpd[i * QP] = f2bf(qv[i] * e);
            kpd[i * QP] = f2bf(ky[i] * __builtin_amdgcn_rcpf(e));
        }
    }
    const int fr = c.lane & 15, fq = c.lane >> 4;
    const int tt = c.wave & 3, vh = c.wave >> 2;
    bf16x8 sf[2][4][4];
#pragma unroll
    for (int dir = 0; dir < 2; ++dir) {
        const bf16_t* Sg = Lg + ((size_t)((dir * 16 + b * 4 + h) * 128 + (dir ? 127 - ch : ch))) * 16384;
#pragma unroll
        for (int vt = 0; vt < 4; ++vt)
#pragma unroll
            for (int ks = 0; ks < 4; ++ks) sf[dir][vt][ks] = *(const bf16x8*)(Sg + (size_t)((vh * 4 + vt) * 16 + fr) * 128 + fq * 8 + ks * 32);
    }
    bf16_t* grow = Z + (row0 + tt * 16 + fr) * LDZ + ZG + h * 128;
    u32x2 gwv[4];
#pragma unroll
    for (int vt = 0; vt < 4; ++vt) gwv[vt] = *(const u32x2*)(grow + (vh * 4 + vt) * 16 + fq * 4);
    __syncthreads();
    f32x4 acc[4];
#pragma unroll
    for (int vt = 0; vt < 4; ++vt) acc[vt] = (f32x4){0.f, 0.f, 0.f, 0.f};
#pragma unroll
    for (int dir = 0; dir < 2; ++dir) {
        bf16x8 qf[4];
#pragma unroll
        for (int ks = 0; ks < 4; ++ks) qf[ks] = *(const bf16x8*)(Qp + (size_t)(dir * 64 + tt * 16 + fr) * QP + ks * 32 + fq * 8);
        f32x4 at[4];
#pragma unroll
        for (int st = 0; st < 4; ++st) {
            f32x4 a = (f32x4){0.f, 0.f, 0.f, 0.f};
            const bf16_t* kr = Kp + (size_t)(dir * 64 + st * 16 + fr) * QP + fq * 8;
#pragma unroll
            for (int ks = 0; ks < 4; ++ks) a = __builtin_amdgcn_mfma_f32_16x16x32_bf16(*(const bf16x8*)(kr + ks * 32), qf[ks], a, 0, 0, 0);
#pragma unroll
            for (int j = 0; j < 4; ++j) { const int s = st * 16 + fq * 4 + j, t = tt * 16 + fr; const bool ok = dir ? (s >= t) : (s <= t); a[j] = ok ? a[j] : 0.f; }
            at[st] = a;
        }
#pragma unroll
        for (int kk = 0; kk < 2; ++kk) {
            u32x4 pw; pw.x = cvt_pk_bf16(at[2 * kk][0], at[2 * kk][1]); pw.y = cvt_pk_bf16(at[2 * kk][2], at[2 * kk][3]); pw.z = cvt_pk_bf16(at[2 * kk + 1][0], at[2 * kk + 1][1]); pw.w = cvt_pk_bf16(at[2 * kk + 1][2], at[2 * kk + 1][3]);
            const bf16x8 pf = __builtin_bit_cast(bf16x8, pw);
#pragma unroll
            for (int vt = 0; vt < 4; ++vt) {
                const int vx = ((((vh * 4 + vt) * 16 + fr) >> 3) & 7) << 3, vc = (2 * kk) * 16 + fq * 4; const bf16_t* vrow = Vt + (size_t)((vh * 4 + vt) * 16 + fr) * SP;
                u32x4 vw; const u32x2 v0 = *(const u32x2*)(vrow + (vc ^ vx)), v1 = *(const u32x2*)(vrow + ((vc + 16) ^ vx)); vw.x = v0.x; vw.y = v0.y; vw.z = v1.x; vw.w = v1.y;
                acc[vt] = __builtin_amdgcn_mfma_f32_16x16x32_bf16(__builtin_bit_cast(bf16x8, vw), pf, acc[vt], 0, 0, 0);
            }
        }
        if (A_MASK & 2) {
#pragma unroll
        for (int vt = 0; vt < 4; ++vt)
#pragma unroll
            for (int ks = 0; ks < 4; ++ks) acc[vt] = __builtin_amdgcn_mfma_f32_16x16x32_bf16(sf[dir][vt][ks], qf[ks], acc[vt], 0, 0, 0);
        }
    }
    float ss = 0.f;
#pragma unroll
    for (int vt = 0; vt < 4; ++vt) ss += (acc[vt][0] * acc[vt][0] + acc[vt][1] * acc[vt][1]) + (acc[vt][2] * acc[vt][2] + acc[vt][3] * acc[vt][3]);
    ss += __shfl_xor(ss, 16); ss += __shfl_xor(ss, 32);
    if (fq == 0) red[vh * 64 + tt * 16 + fr] = ss;
    __syncthreads();
    const float rstd = rsqrtf((red[tt * 16 + fr] + red[64 + tt * 16 + fr]) * (1.f / 128.f) + EPS);
#pragma unroll
    for (int vt = 0; vt < 4; ++vt) {
        const int v0 = (vh * 4 + vt) * 16 + fq * 4;
        const u32x2 gw = gwv[vt];
        const f32x4 nw = *(const f32x4*)(a_norm + v0);
        const float g0 = bf_lo(gw.x), g1 = bf_hi(gw.x), g2 = bf_lo(gw.y), g3 = bf_hi(gw.y);
        u32x2 o;
        o.x = cvt_pk_bf16(acc[vt][0] * rstd * nw[0] * g0 * sigmoidf_(g0), acc[vt][1] * rstd * nw[1] * g1 * sigmoidf_(g1));
        o.y = cvt_pk_bf16(acc[vt][2] * rstd * nw[2] * g2 * sigmoidf_(g2), acc[vt][3] * rstd * nw[3] * g3 * sigmoidf_(g3));
        *(u32x2*)(grow + v0 + (ocol - ZG)) = o;
    }
    __syncthreads();
}

__device__ __forceinline__ void p3_issue_raw(unsigned char* lds_raw_, const bf16_t* Z, int unit, int tid, int wave, u32x4 (&vreg)[2]) {
    constexpr int RAWB = 91136;
    const int ch = unit & 127, h = (unit >> 7) & 3, b = unit >> 9;
    const bf16_t* zt = Z + ((size_t)b * SEQ + (size_t)ch * 64) * LDZ + h * 128;
    LAS unsigned char* l3 = (LAS unsigned char*)lds_raw_ + RAWB;
#pragma unroll
    for (int i = 0; i < 2; ++i) { const int chunk = tid + 512 * i; const bf16_t* p = zt + (size_t)(chunk >> 4) * LDZ + (chunk & 15) * 8;
        __builtin_amdgcn_global_load_lds((const unsigned*)(p + ZFF), (LAS unsigned*)(l3 + 0 * 16384 + i * 8192 + wave * 1024), 16, 0, 0);
        __builtin_amdgcn_global_load_lds((const unsigned*)(p + ZFB), (LAS unsigned*)(l3 + 1 * 16384 + i * 8192 + wave * 1024), 16, 0, 0);
        __builtin_amdgcn_global_load_lds((const unsigned*)(p + ZQ),  (LAS unsigned*)(l3 + 2 * 16384 + i * 8192 + wave * 1024), 16, 0, 0);
        vreg[i] = *(const u32x4*)(p + ZI); }
}
#define LDS_BAR() do { asm volatile("s_waitcnt lgkmcnt(0)" ::: "memory"); __builtin_amdgcn_s_barrier(); asm volatile("" ::: "memory"); } while (0)
__device__ __forceinline__ void hgrn_pass3_phase(unsigned char* lds_raw_, bf16_t* Z, const float* a_norm, const bf16_t* Lg, int bid, int G, int ocol) {
    constexpr int QP = 136, SP = 72, RAWB = 91136;
    bf16_t* Qp = (bf16_t*)lds_raw_;
    bf16_t* Kp = Qp + 2 * 64 * QP;
    bf16_t* Vt = Kp + 2 * 64 * QP;
    float* red = (float*)(Vt + 128 * SP) + 512;
    const bf16_t* Raw = (const bf16_t*)(lds_raw_ + RAWB);
    u32x4 vreg[2];
    { const Ctx c0 = make_ctx(lds_raw_); if (bid < 2048) p3_issue_raw(lds_raw_, Z, bid, c0.tid, c0.wave, vreg); }
#pragma unroll 1
    for (int unit = bid; unit < 2048; unit += G) {
        const Ctx c = make_ctx(lds_raw_);
        const int ch = unit & 127, h = (unit >> 7) & 3, b = unit >> 9;
        const size_t row0 = (size_t)b * SEQ + (size_t)ch * 64;
#pragma unroll
        for (int i = 0; i < 2; ++i) { const int chunk = c.tid + 512 * i; const int s = chunk >> 4, part = chunk & 15;
            const u32x4 vv = vreg[i]; bf16_t* vd = Vt + (part * 8) * SP + (s ^ ((part & 7) << 3));
            vd[0 * SP] = (bf16_t)(vv.x & 0xffffu); vd[1 * SP] = (bf16_t)(vv.x >> 16); vd[2 * SP] = (bf16_t)(vv.y & 0xffffu); vd[3 * SP] = (bf16_t)(vv.y >> 16);
            vd[4 * SP] = (bf16_t)(vv.z & 0xffffu); vd[5 * SP] = (bf16_t)(vv.z >> 16); vd[6 * SP] = (bf16_t)(vv.w & 0xffffu); vd[7 * SP] = (bf16_t)(vv.w >> 16); }
        asm volatile("s_waitcnt vmcnt(0)" ::: "memory");
        __syncthreads();
        {
            const int dir = c.tid >> 8, half = (c.tid >> 7) & 1, k = c.tid & 127;
            float gl[32], ky[32], qv[32];
            {
                const bf16_t* zr = Raw + (dir * 64 + half * 32) * 128 + k; const bf16_t* qr = Raw + (128 + half * 32) * 128 + k;
#pragma unroll
                for (int i = 0; i < 32; ++i) { gl[i] = bf2f(zr[i * 128]); qv[i] = bf2f(qr[i * 128]); }
            }
            const float run = gate_cumsum(gl, ky, dir);
            const float rsub = (half == dir) ? run : 0.f;
            bf16_t* qpd = Qp + (dir * 64 + half * 32) * QP + k; bf16_t* kpd = Kp + (dir * 64 + half * 32) * QP + k;
#pragma unroll
            for (int i = 0; i < 32; ++i) {
                const float e = __expf(gl[i] - rsub);
                qpd[i * QP] = f2bf(qv[i] * e);
                kpd[i * QP] = f2bf(ky[i] * __builtin_amdgcn_rcpf(e));
            }
        }
        const int fr = c.lane & 15, fq = c.lane >> 4;
        const int tt = c.wave & 3, vh = c.wave >> 2;
        bf16x8 sf[2][4][4];
#pragma unroll
        for (int dir = 0; dir < 2; ++dir) {
            const bf16_t* Sg = Lg + ((size_t)((dir * 16 + b * 4 + h) * 128 + (dir ? 127 - ch : ch))) * 16384;
#pragma unroll
            for (int vt = 0; vt < 4; ++vt)
#pragma unroll
                for (int ks = 0; ks < 4; ++ks) sf[dir][vt][ks] = *(const bf16x8*)(Sg + (size_t)((vh * 4 + vt) * 16 + fr) * 128 + fq * 8 + ks * 32);
        }
        bf16_t* grow = Z + (row0 + tt * 16 + fr) * LDZ + ZG + h * 128;
        u32x2 gwv[4];
#pragma unroll
        for (int vt = 0; vt < 4; ++vt) gwv[vt] = *(const u32x2*)(grow + (vh * 4 + vt) * 16 + fq * 4);
        LDS_BAR();
        if (unit + G < 2048) p3_issue_raw(lds_raw_, Z, unit + G, c.tid, c.wave, vreg);
        f32x4 acc[4];
#pragma unroll
        for (int vt = 0; vt < 4; ++vt) acc[vt] = (f32x4){0.f, 0.f, 0.f, 0.f};
#pragma unroll
        for (int dir = 0; dir < 2; ++dir) {
            bf16x8 qf[4];
#pragma unroll
            for (int ks = 0; ks < 4; ++ks) qf[ks] = *(const bf16x8*)(Qp + (size_t)(dir * 64 + tt * 16 + fr) * QP + ks * 32 + fq * 8);
            f32x4 at[4];
#pragma unroll
            for (int st = 0; st < 4; ++st) {
                f32x4 a = (f32x4){0.f, 0.f, 0.f, 0.f};
                const bf16_t* kr = Kp + (size_t)(dir * 64 + st * 16 + fr) * QP + fq * 8;
#pragma unroll
                for (int ks = 0; ks < 4; ++ks) a = __builtin_amdgcn_mfma_f32_16x16x32_bf16(*(const bf16x8*)(kr + ks * 32), qf[ks], a, 0, 0, 0);
#pragma unroll
                for (int j = 0; j < 4; ++j) { const int s = st * 16 + fq * 4 + j, t = tt * 16 + fr; const bool ok = dir ? (s >= t) : (s <= t); a[j] = ok ? a[j] : 0.f; }
                at[st] = a;
            }
#pragma unroll
            for (int kk = 0; kk < 2; ++kk) {
                u32x4 pw; pw.x = cvt_pk_bf16(at[2 * kk][0], at[2 * kk][1]); pw.y = cvt_pk_bf16(at[2 * kk][2], at[2 * kk][3]); pw.z = cvt_pk_bf16(at[2 * kk + 1][0], at[2 * kk + 1][1]); pw.w = cvt_pk_bf16(at[2 * kk + 1][2], at[2 * kk + 1][3]);
                const bf16x8 pf = __builtin_bit_cast(bf16x8, pw);
#pragma unroll
                for (int vt = 0; vt < 4; ++vt) {
                    const int vx = ((((vh * 4 + vt) * 16 + fr) >> 3) & 7) << 3, vc = (2 * kk) * 16 + fq * 4; const bf16_t* vrow = Vt + (size_t)((vh * 4 + vt) * 16 + fr) * SP;
                    u32x4 vw; const u32x2 v0 = *(const u32x2*)(vrow + (vc ^ vx)), v1 = *(const u32x2*)(vrow + ((vc + 16) ^ vx)); vw.x = v0.x; vw.y = v0.y; vw.z = v1.x; vw.w = v1.y;
                    acc[vt] = __builtin_amdgcn_mfma_f32_16x16x32_bf16(__builtin_bit_cast(bf16x8, vw), pf, acc[vt], 0, 0, 0);
                }
            }
            if (A_MASK & 2) {
#pragma unroll
            for (int vt = 0; vt < 4; ++vt)
#pragma unroll
                for (int ks = 0; ks < 4; ++ks) acc[vt] = __builtin_amdgcn_mfma_f32_16x16x32_bf16(sf[dir][vt][ks], qf[ks], acc[vt], 0, 0, 0);
            }
        }
        float ss = 0.f;
#pragma unroll
        for (int vt = 0; vt < 4; ++vt) ss += (acc[vt][0] * acc[vt][0] + acc[vt][1] * acc[vt][1]) + (acc[vt][2] * acc[vt][2] + acc[vt][3] * acc[vt][3]);
        ss += __shfl_xor(ss, 16); ss += __shfl_xor(ss, 32);
        if (fq == 0) red[vh * 64 + tt * 16 + fr] = ss;
        LDS_BAR();
        const float rstd = rsqrtf((red[tt * 16 + fr] + red[64 + tt * 16 + fr]) * (1.f / 128.f) + EPS);
#pragma unroll
        for (int vt = 0; vt < 4; ++vt) {
            const int v0 = (vh * 4 + vt) * 16 + fq * 4;
            const u32x2 gw = gwv[vt];
            const f32x4 nw = *(const f32x4*)(a_norm + v0);
            const float g0 = bf_lo(gw.x), g1 = bf_hi(gw.x), g2 = bf_lo(gw.y), g3 = bf_hi(gw.y);
            u32x2 o;
            o.x = cvt_pk_bf16(acc[vt][0] * rstd * nw[0] * g0 * sigmoidf_(g0), acc[vt][1] * rstd * nw[1] * g1 * sigmoidf_(g1));
            o.y = cvt_pk_bf16(acc[vt][2] * rstd * nw[2] * g2 * sigmoidf_(g2), acc[vt][3] * rstd * nw[3] * g3 * sigmoidf_(g3));
            *(u32x2*)(grow + v0 + (ocol - ZG)) = o;
        }
        LDS_BAR();
    }
}

#define XB_TMO      128
#define XB_XCNT(j)  (256  + 64 * (j))
#define XB_XSUB(j)  (1280 + 64 * (j))
#define XB_XGEN(j)  (2304 + 64 * (j))
#define XB_TOP      3328
#define XB_TOPGEN   3392
#define XCD_BAR_WORDS 3456
#define XB_SPIN_CAP (1u << 20)
constexpr size_t WS_BAR = 896 * 1024;
constexpr int LDS_MISC_OFF = LDS_BYTES - 64;
__device__ __forceinline__ unsigned xb_ld(unsigned* p)              { return __hip_atomic_load(p, __ATOMIC_RELAXED, __HIP_MEMORY_SCOPE_AGENT); }
__device__ __forceinline__ unsigned xb_add(unsigned* p, unsigned v) { return __hip_atomic_fetch_add(p, v, __ATOMIC_RELAXED, __HIP_MEMORY_SCOPE_AGENT); }
__device__ __forceinline__ unsigned xb_xcc_id() { return (unsigned)__builtin_amdgcn_s_getreg((3 << 11) | 20) & 0xFu; }
#define XB_SPIN(cond, bar) do { unsigned _sp = 0; while (cond) { __builtin_amdgcn_s_sleep(1); \
    if ((++_sp & 255u) == 0u) { if (xb_ld(&(bar)[XB_TMO])) break; if (_sp > XB_SPIN_CAP) { atomicAdd(&(bar)[XB_TMO], 1u); break; } } } } while (0)
struct XcdBarrier { unsigned* bar; unsigned x; volatile LAS unsigned* st; };
__device__ __forceinline__ XcdBarrier xcd_barrier_post(unsigned* bar, volatile LAS unsigned* st) {
    XcdBarrier b; b.bar = bar; b.x = xb_xcc_id(); b.st = st;
    if (threadIdx.x == 0) (void)xb_add(&bar[XB_XCNT(b.x)], 1u);
    return b;
}
__device__ __forceinline__ void xcd_barrier_complete(unsigned* bar, unsigned x, unsigned& nloc, unsigned& nx) {
    const unsigned G = gridDim.x * gridDim.y * gridDim.z;
    unsigned sum, cnt, mine, sp = 0u;
    for (;;) {
        sum = 0u; cnt = 0u; mine = 0u;
#pragma unroll
        for (unsigned j = 0; j < 16; ++j) { const unsigned c = xb_ld(&bar[XB_XCNT(j)]); sum += c; cnt += (c > 0u) ? 1u : 0u; mine = (j == x) ? c : mine; }
        if (sum == G) break;
        __builtin_amdgcn_s_sleep(1);
        if ((++sp & 255u) == 0u) { if (xb_ld(&bar[XB_TMO])) break; if (sp > XB_SPIN_CAP) { atomicAdd(&bar[XB_TMO], 1u); break; } }
    }
    nloc = mine > 0u ? mine : 1u; nx = cnt > 0u ? cnt : 1u;
}
__device__ __forceinline__ void xcd_barrier(const XcdBarrier& b) {
    asm volatile("s_waitcnt vmcnt(0)" ::: "memory");
    __syncthreads();
    if (threadIdx.x == 0) {
        unsigned* bar = b.bar;
        __builtin_amdgcn_s_waitcnt(0);
        unsigned nloc = b.st[0], nx = b.st[1];
        if (nloc == 0u) { xcd_barrier_complete(bar, b.x, nloc, nx); b.st[0] = nloc; b.st[1] = nx; }
        const unsigned old = xb_add(&bar[XB_XSUB(b.x)], 1u);
        const unsigned gen = old / nloc;
        if (old + 1u == (gen + 1u) * nloc) {
            __builtin_amdgcn_fence(__ATOMIC_RELEASE, "agent");
            asm volatile("s_waitcnt vmcnt(0)" ::: "memory");
            const unsigned og = xb_add(&bar[XB_TOP], 1u);
            const unsigned tg = og / nx;
            if (og + 1u == (tg + 1u) * nx) xb_add(&bar[XB_TOPGEN], 1u);
            else XB_SPIN(xb_ld(&bar[XB_TOPGEN]) == tg, bar);
            __builtin_amdgcn_fence(__ATOMIC_ACQUIRE, "agent");
            xb_add(&bar[XB_XGEN(b.x)], 1u);
            asm volatile("s_waitcnt vmcnt(0)" ::: "memory");
        } else {
            XB_SPIN(xb_ld(&bar[XB_XGEN(b.x)]) == gen, bar);
            __builtin_amdgcn_fence(__ATOMIC_ACQUIRE, "agent");
            asm volatile("s_waitcnt vmcnt(0)" ::: "memory");
        }
    }
    __syncthreads();
}

struct Args { const float* in[14]; float* out; unsigned char* ws; int ph_lo, ph_hi; };
typedef __attribute__((address_space(4))) const unsigned long long* kargp_t;
__device__ __forceinline__ kargp_t kargs_now() { kargp_t p = (kargp_t)__builtin_amdgcn_kernarg_segment_ptr(); asm volatile("" : "+s"(p)); return p; }
#define GAS1 __attribute__((address_space(1)))
#define KIN(i) ((const float*)(const GAS1 float*)ka[i])
#define KOUT ((float*)(GAS1 float*)ka[14])
#define KWS ((unsigned char*)(GAS1 unsigned char*)ka[15])

__global__ void __launch_bounds__(512, 2) fwd_megakernel(Args a) {
    extern __shared__ __attribute__((aligned(16))) unsigned char lds_raw[];
    LAS unsigned char* ldsl = (LAS unsigned char*)lds_raw;
    const int ph_lo = a.ph_lo, ph_hi = a.ph_hi;
    XcdBarrier xbar; xbar.bar = (unsigned*)(a.ws + WS_BAR); xbar.x = 0; xbar.st = (volatile LAS unsigned*)(ldsl + LDS_MISC_OFF);
    if (USE_XB) {
        if (threadIdx.x < 16) ((LAS unsigned*)(ldsl + LDS_MISC_OFF))[threadIdx.x] = 0u;
        if (blockIdx.x == 0) for (int i = threadIdx.x; i < 4096; i += 512) ((unsigned*)(a.ws + WS_BAR))[i] = 0u;
        __syncthreads();
    }
    for (int ph = ph_lo; ph < ph_hi; ++ph) {
        if (ph > ph_lo) { if (USE_XB && ph > ph_lo + 1) { xcd_barrier(xbar); } else { cg::this_grid().sync(); if (USE_XB) xbar = xcd_barrier_post((unsigned*)(a.ws + WS_BAR), (volatile LAS unsigned*)(ldsl + LDS_MISC_OFF)); } }
        const Ctx c = make_ctx(lds_raw);
        const kargp_t ka = kargs_now();
        unsigned char* ws = KWS;
        bf16_t* Z = (bf16_t*)(ws + WS_Z);
        bf16_t* Wb = (bf16_t*)(ws + WS_W);
        bf16_t* Lg = (bf16_t*)(ws + WS_L);
        float* DEC = (float*)(ws + WS_DEC);
        if (ph == NPH - 1) { if (PHON(10)) rms_rows_f32_inplace(c, KOUT, KIN(13)); continue; }
        const int nrep = DUP_THIN ? 2 : 1;
        const int l = ph / 9, k9 = ph % 9; const int k = k9 < 7 ? k9 : k9 + 1;
        if (k == 0 && PHON(0)) {
            for (int rep = 0; rep < nrep; ++rep) phase_pre(c, l, KIN(1), KIN(2), KIN(3), KIN(5), KIN(8), KIN(9), KIN(10), KIN(11), KIN(12), l == 0 ? KIN(0) : KOUT, ws);
            __syncthreads();
        } else if (k == 1 && PHON(1)) {
            pg8::Gemm g{Z + ZXN, (const bf16_t*)((const char*)Wb + W_IN), T, NZ, D, LDZ}; pg8::StaticOrder S; S.init(T, NZ, c.G, c.bid);
            pg8::EpiZ E{Z, LDZ, (const float*)(ws + WS_LOW), (const f32x2*)(ws + WS_ROPE)};
            if (DUP_GEMM) pg8::gemm_phase<pg8::EpiZ>(ldsl, g, S, E, c.tid);
            pg8::gemm_phase<pg8::EpiZ>(ldsl, g, S, E, c.tid);
        } else if (k == 2 && PHON(2)) {
            const float* lbl = KIN(3);
            for (int u = c.bid; u < 512 + 256 + 2048; u += c.G) {
                const Ctx c = make_ctx(lds_raw);
                if (u < 512) { if (BR_MASK & 1) branch_c_unit(c, Z, KIN(7) + l * 8, u); }
                else if (u < 768) { if (BR_MASK & 2) branch_b_unit(c, Z, (const bf16_t*)(ws + WS_WSB), KIN(6) + (size_t)l * 512, u - 512); }
                else if (BR_MASK & 4) { if (DUP_P1) hgrn_pass1_unit(c, Z, Lg, DEC, (float*)(ws + WS_ENR), u - 768); hgrn_pass1_unit(c, Z, Lg, DEC, (float*)(ws + WS_ENR), u - 768); }
            }
        } else if (k == 3 && PHON(3)) {
            hgrn_scan(c, Lg, DEC, (const float*)(ws + WS_ENR));
        } else if (k == 4 && PHON(4)) {
            hgrn_pass3_phase(lds_raw, Z, KIN(4) + (size_t)l * 128, Lg, c.bid, c.G, ZG);
        } else if (k == 5 && PHON(5)) {
            bf16_t* Mg = (bf16_t*)(ws + WS_MERGED); bf16_t* Sg = (bf16_t*)(ws + WS_SST);
            pg8::StaticOrder S; S.init(T, D, c.G, c.bid);
#pragma unroll 1
            for (int rep = 0; rep < 1 + DUP_GEMM; ++rep)
#pragma unroll 1
            for (int b = 0; b < 3; ++b) {
                pg8::Gemm gg{Z + ZXN, (const bf16_t*)((const char*)Wb + W_IN) + (size_t)(NZ + b * D) * D, T, D, D, LDZ};
                pg8::EpiAct<0> Eg{b == 0 ? Mg : Sg, D, nullptr};
                { const Ctx c2 = make_ctx(lds_raw); pg8::gemm_phase<pg8::EpiAct<0>>(ldsl, gg, S, Eg, c2.tid); }
                const int ycol = b == 0 ? ZG : (b == 1 ? ZU : ZCQ);
                pg8::Gemm gp{Z + ycol, (const bf16_t*)((const char*)Wb + W_BR) + (size_t)b * D * 512, T, D, 512, LDZ};
                const Ctx c3 = make_ctx(lds_raw);
                if (b == 0) { pg8::EpiMul<0> Em{Mg, Sg, D}; pg8::gemm_phase<pg8::EpiMul<0>>(ldsl, gp, S, Em, c3.tid); }
                else { pg8::EpiMul<1> Em{Mg, Sg, D}; pg8::gemm_phase<pg8::EpiMul<1>>(ldsl, gp, S, Em, c3.tid); }
            }
        } else if (k == 6 && PHON(6)) {
            pg8::Gemm g{(const bf16_t*)(ws + WS_MERGED), (const bf16_t*)((const char*)Wb + W_OUT), T, D, D, D}; pg8::StaticOrder S; S.init(T, D, c.G, c.bid);
            pg8::EpiRes<true> E{l == 0 ? KIN(0) : KOUT, KOUT, D, (bf16_t*)(ws + WS_SST), (float*)(ws + WS_SUMSQ)};
            pg8::gemm_phase<pg8::EpiRes<true>>(ldsl, g, S, E, c.tid);
        } else if (k == 7 && PHON(7)) {
            for (int rep = 0; rep < nrep; ++rep) rms_rows_bf16(c, KOUT, KIN(10) + (size_t)l * D, (bf16_t*)(ws + WS_HN), D);
        } else if (k == 8 && PHON(8)) {
            pg8::Gemm g{(const bf16_t*)(ws + WS_SST), (const bf16_t*)((const char*)Wb + W_UP), T, DFF, D, D}; pg8::StaticOrder S; S.init(T, DFF, c.G, c.bid);
            pg8::EpiAct<1> E{Z, DFF, (const float*)(ws + WS_SUMSQ)};
            pg8::gemm_phase<pg8::EpiAct<1>>(ldsl, g, S, E, c.tid);
        } else if (k == 9 && PHON(9)) {
            pg8::Gemm g{Z, (const bf16_t*)((const char*)Wb + W_DN), T, D, DFF, DFF}; pg8::StaticOrder S; S.init(T, D, c.G, c.bid);
            pg8::EpiRes<false> E{nullptr, KOUT, D, (bf16_t*)(ws + WS_SST), nullptr};
            pg8::gemm_phase<pg8::EpiRes<false>>(ldsl, g, S, E, c.tid);
        }
    }
}

extern "C" void kernel_launch(void* const* d_in, const int* in_sizes, int n_in, void* d_out, int out_size, void* d_ws, size_t ws_size, hipStream_t stream) {
    static int grid = 0;
    if (grid == 0) {
        if (n_in != 14 || out_size != T * D || ws_size < WS_END) { fprintf(stderr, "kernel_launch: unexpected shapes (n_in %d out %d ws %zu)\n", n_in, out_size, ws_size); grid = -1; return; }
        int dev = 0, cus = 0, per_cu = 0;
        hipGetDevice(&dev); hipDeviceGetAttribute(&cus, hipDeviceAttributeMultiprocessorCount, dev);
        if (hipFuncSetAttribute((const void*)fwd_megakernel, hipFuncAttributeMaxDynamicSharedMemorySize, LDS_BYTES) != hipSuccess) { fprintf(stderr, "kernel_launch: hipFuncSetAttribute failed\n"); grid = -1; return; }
        if (hipOccupancyMaxActiveBlocksPerMultiprocessor(&per_cu, (const void*)fwd_megakernel, 512, LDS_BYTES) != hipSuccess || per_cu < 1) { fprintf(stderr, "kernel_launch: occupancy query says %d\n", per_cu); per_cu = 1; }
        (void)hipGetLastError();
        grid = cus * 1;
    }
    if (grid < 0) return;
    Args a{};
    for (int i = 0; i < 14; ++i) a.in[i] = (const float*)d_in[i];
    a.out = (float*)d_out; a.ws = (unsigned char*)d_ws;
#if MK_ONE_LAUNCH
    a.ph_lo = 0; a.ph_hi = NPH;
    void* args[] = {&a};
    hipError_t e = hipLaunchCooperativeKernel((const void*)fwd_megakernel, dim3(grid), dim3(512), args, LDS_BYTES, stream);
    if (e != hipSuccess) fprintf(stderr, "cooperative launch failed: %s (grid %d)\n", hipGetErrorString(e), grid);
#else
    for (int ph = 0; ph < NPH; ++ph) {
        a.ph_lo = ph; a.ph_hi = ph + 1;
        hipLaunchKernelGGL(fwd_megakernel, dim3(grid), dim3(512), LDS_BYTES, stream, a);
    }
#endif
}
```

```cpp
#include <hip/hip_runtime.h>
#include <hip/hip_cooperative_groups.h>
#include <cstdio>
#include <cstdint>
namespace cg = cooperative_groups;

#ifndef PH_MASK
#define PH_MASK 0x7ff
#endif
#ifndef BR_MASK
#define BR_MASK 7
#endif
#ifndef A_MASK
#define A_MASK 3
#endif
#ifndef TPROBE_A
#define TPROBE_A -1
#endif
#ifndef TPROBE_B
#define TPROBE_B -1
#endif
#ifndef DUP_GEMM
#define DUP_GEMM 0
#endif
#ifndef DUP_SYNC
#define DUP_SYNC 0
#endif
#ifndef DUP_THIN
#define DUP_THIN 0
#endif
#ifndef USE_XB
#define USE_XB 1
#endif
#ifndef DUP_P1
#define DUP_P1 0
#endif
#ifndef DUP_P3
#define DUP_P3 0
#endif
#ifndef DUP_C
#define DUP_C 0
#endif
#define PHON(n) ((PH_MASK >> (n)) & 1)
#ifndef MK_ONE_LAUNCH
#define MK_ONE_LAUNCH 1
#endif

#define LAS __attribute__((address_space(3)))
typedef unsigned short bf16_t;
typedef short bf16x8 __attribute__((ext_vector_type(8)));
typedef float f32x4 __attribute__((ext_vector_type(4)));
typedef float f32x2 __attribute__((ext_vector_type(2)));
typedef unsigned u32x4 __attribute__((ext_vector_type(4)));
typedef unsigned u32x2 __attribute__((ext_vector_type(2)));

constexpr int T = 32768, SEQ = 8192, D = 1024, DFF = 4096, DIN = 7424, NZ = 4352, LDZ = 5376, DEPTH = 2;
constexpr int ZQ = 0, ZI = 512, ZFF = 1024, ZFB = 1536, ZG = 2048, ZU = 2560, ZV = 3072, ZCQ = 3584, ZCK = 4096, ZCV = 4224, ZXN = 4352;
constexpr float EPS = 1e-6f;
constexpr size_t MiB = 1u << 20;
constexpr size_t WS_ROPE = 0;
constexpr size_t WS_WSB = 1 * MiB;
constexpr size_t WS_LOW = 640 * 1024;
constexpr size_t WS_ETN = 1 * MiB + 256 * 1024;
constexpr size_t WS_SUMSQ = 1 * MiB + 512 * 1024;
constexpr size_t WS_DEC = 2 * MiB;
constexpr size_t WS_W = 4 * MiB;
constexpr size_t W_IN = 0, W_BR = (size_t)DIN * D * 2, W_OUT = W_BR + (size_t)3 * D * 512 * 2, W_UP = W_OUT + (size_t)D * D * 2, W_DN = W_UP + (size_t)DFF * D * 2;
constexpr size_t WS_Z = 40 * MiB;
constexpr size_t WS_L = 376 * MiB;
constexpr size_t WS_MERGED = WS_L, WS_SST = WS_L + 64 * MiB, WS_HN = WS_L;
constexpr size_t WS_ENR = 504 * MiB;
constexpr size_t WS_END = 506 * MiB;
constexpr int LDS_BYTES = 147456;
constexpr int NPH = 9 * DEPTH + 1;

typedef __bf16 bf16v2_t __attribute__((ext_vector_type(2)));
__device__ __forceinline__ unsigned cvt_pk_bf16(float lo, float hi) { const f32x2 v = {lo, hi}; const bf16v2_t b = __builtin_convertvector(v, bf16v2_t); return __builtin_bit_cast(unsigned, b); }
__device__ __forceinline__ float bf_lo(unsigned w) { return __uint_as_float(w << 16); }
__device__ __forceinline__ float bf_hi(unsigned w) { return __uint_as_float(w & 0xffff0000u); }
__device__ __forceinline__ float bf2f(bf16_t b) { return __uint_as_float(((unsigned)b) << 16); }
__device__ __forceinline__ bf16_t f2bf(float f) { return (bf16_t)(cvt_pk_bf16(f, 0.f) & 0xffffu); }
__device__ __forceinline__ float wave_sum(float v) {
#pragma unroll
    for (int o = 1; o < 64; o <<= 1) v += __shfl_xor(v, o);
    return v;
}
__device__ __forceinline__ float gelu_tanh(float x) { const float u = 1.5957691216f * (x + 0.044715f * x * x * x); return x * __builtin_amdgcn_rcpf(1.0f + __expf(-u)); }
__device__ __forceinline__ float sigmoidf_(float x) { return __builtin_amdgcn_rcpf(1.0f + __expf(-x)); }

namespace pg8 {
constexpr int BM = 256, BK = 64, HALF = 128, HTB = HALF * BK * 2, STAGE_BYTES = 8 * HTB, NXCD = 8, WGM = 8;
__host__ __device__ __forceinline__ int lds_byte(int r, int c) { const int st = (r >> 4) * 2 + (c >> 5), rr = r & 15, cc = c & 31, ob = rr * 64 + cc * 2; return st * 1024 + (ob ^ (((ob >> 9) & 1) << 5)); }
__host__ __device__ __forceinline__ void stage_rc(int b, int& R, int& C) { const int st = b / 1024, sb = b % 1024, swz = sb ^ (((sb >> 9) & 1) << 5); R = (st >> 1) * 16 + swz / 64; C = (st & 1) * 32 + (swz % 64) / 2; }
__host__ __device__ __forceinline__ int perm32(int rho) { const int n = rho >> 4, i = rho & 15; return 8 * (i >> 2) + 4 * n + (i & 3); }

struct Unit { int pm, pn; };
struct Gemm { const bf16_t* A; const bf16_t* Bt; int M, N, K, lda; };

struct StaticOrder {
    int nM, nN, nwg, G, c;
    __device__ void init(int M, int N, int G_, int c_) { nM = M / BM; nN = N / BM; nwg = nM * nN; G = G_; c = c_; }
    __device__ bool next(int i, Unit& u) const {
        const long L = (long)i * G + c; if (L >= nwg) return false;
        int wgid = (int)L; { const int q = nwg / NXCD, r = nwg % NXCD, xcd = wgid % NXCD, off = wgid / NXCD; wgid = (xcd < r ? xcd * (q + 1) : r * (q + 1) + (xcd - r) * q) + off; }
        const int nig = WGM * nN, gid = wgid / nig, fm = gid * WGM, gsz = (nM - fm) < WGM ? (nM - fm) : WGM;
        u.pm = fm + ((wgid % nig) % gsz); u.pn = (wgid % nig) / gsz; return true;
    }
};

typedef const f32x4 (&AccRef)[2][2][4][2];

struct EpiZ {
    static constexpr bool PERM = true;
    bf16_t* O; int ldc; const float* low; const f32x2* rope;
    __device__ __forceinline__ void operator()(AccRef acc, const Unit& u, int wr, int wc, int fr, int fq) const {
        const int row0 = u.pm * BM + wr * 64 + fr, col0 = u.pn * BM + wc * 32 + 8 * fq;
        const int mode = (u.pn >= 10 && u.pn < 14) ? 1 : ((u.pn >= 4 && u.pn < 8) ? 2 : (u.pn >= 14 ? 3 : 0));
        const bool rlane = ((wc & 1) == 0) && (fq < 2);
#pragma unroll
        for (int bj = 0; bj < 2; ++bj) {
            f32x4 l0 = (f32x4){0.f, 0.f, 0.f, 0.f}, l1 = l0;
            if (mode == 2) { const float* lp = low + (col0 + bj * HALF - 1024); l0 = *(const f32x4*)lp; l1 = *(const f32x4*)(lp + 4); }
#pragma unroll
            for (int ai = 0; ai < 2; ++ai)
#pragma unroll
                for (int m = 0; m < 4; ++m) { bf16_t* rowp = O + (size_t)(row0 + ai * HALF + m * 16) * ldc + col0;
                    f32x4 v0 = acc[ai][bj][m][0], v1 = acc[ai][bj][m][1];
                    if (mode == 1) {
#pragma unroll
                        for (int j = 0; j < 4; ++j) { v0[j] = gelu_tanh(v0[j]); v1[j] = gelu_tanh(v1[j]); }
                    } else if (mode == 2) {
#pragma unroll
                        for (int j = 0; j < 4; ++j) { v0[j] = __logf(l0[j] + (1.0f - l0[j]) * sigmoidf_(v0[j])); v1[j] = __logf(l1[j] + (1.0f - l1[j]) * sigmoidf_(v1[j])); }
                    } else if (mode == 3 && (u.pn < 16 || bj == 0)) {
                        f32x4 p0, p1;
#pragma unroll
                        for (int j = 0; j < 4; ++j) { p0[j] = __shfl_xor(v0[j], 16); p1[j] = __shfl_xor(v1[j], 16); }
                        if (rlane) {
                            const int pos = (row0 + ai * HALF + m * 16) & (SEQ - 1);
                            const f32x4* rp = (const f32x4*)(rope + (size_t)pos * 8);
                            const f32x4 r0 = rp[0], r1 = rp[1], r2 = rp[2], r3 = rp[3];
                            const float sg = fq == 0 ? -1.f : 1.f;
                            v0[0] = v0[0] * r0.x + sg * p0[0] * r0.y; v0[1] = v0[1] * r0.z + sg * p0[1] * r0.w; v0[2] = v0[2] * r1.x + sg * p0[2] * r1.y; v0[3] = v0[3] * r1.z + sg * p0[3] * r1.w;
                            v1[0] = v1[0] * r2.x + sg * p1[0] * r2.y; v1[1] = v1[1] * r2.z + sg * p1[1] * r2.w; v1[2] = v1[2] * r3.x + sg * p1[2] * r3.y; v1[3] = v1[3] * r3.z + sg * p1[3] * r3.w;
                        }
                    }
                    u32x4 w; w.x = cvt_pk_bf16(v0[0], v0[1]); w.y = cvt_pk_bf16(v0[2], v0[3]); w.z = cvt_pk_bf16(v1[0], v1[1]); w.w = cvt_pk_bf16(v1[2], v1[3]);
                    *(u32x4*)(rowp + bj * HALF) = w; }
        }
    }
};
template <int ACT  > struct EpiAct {
    static constexpr bool PERM = true;
    bf16_t* O; int ldc; const float* sumsq;
    __device__ __forceinline__ void operator()(AccRef acc, const Unit& u, int wr, int wc, int fr, int fq) const {
        const int row0 = u.pm * BM + wr * 64 + fr, col0 = u.pn * BM + wc * 32 + 8 * fq;
#pragma unroll
        for (int ai = 0; ai < 2; ++ai)
#pragma unroll
            for (int m = 0; m < 4; ++m) { bf16_t* rowp = O + (size_t)(row0 + ai * HALF + m * 16) * ldc + col0;
                float r2 = 1.f; if (ACT == 1) r2 = __builtin_amdgcn_rcpf(sumsq[row0 + ai * HALF + m * 16] * (1.f / D) + EPS);
#pragma unroll
                for (int bj = 0; bj < 2; ++bj) { f32x4 v0 = acc[ai][bj][m][0], v1 = acc[ai][bj][m][1];
#pragma unroll
                    for (int j = 0; j < 4; ++j) {
                        if (ACT == 0) { v0[j] = sigmoidf_(v0[j]); v1[j] = sigmoidf_(v1[j]); }
                        else { const float a = fmaxf(v0[j], 0.f), b = fmaxf(v1[j], 0.f); v0[j] = a * a * r2; v1[j] = b * b * r2; } }
                    u32x4 w; w.x = cvt_pk_bf16(v0[0], v0[1]); w.y = cvt_pk_bf16(v0[2], v0[3]); w.z = cvt_pk_bf16(v1[0], v1[1]); w.w = cvt_pk_bf16(v1[2], v1[3]);
                    *(u32x4*)(rowp + bj * HALF) = w; } }
    }
};
template <int MODE  > struct EpiMul {
    static constexpr bool PERM = true;
    bf16_t* Mg; const bf16_t* Sg; int ldc;
    __device__ __forceinline__ void operator()(AccRef acc, const Unit& u, int wr, int wc, int fr, int fq) const {
        const int row0 = u.pm * BM + wr * 64 + fr, col0 = u.pn * BM + wc * 32 + 8 * fq;
#pragma unroll
        for (int ai = 0; ai < 2; ++ai)
#pragma unroll
            for (int m = 0; m < 4; ++m) { const size_t off = (size_t)(row0 + ai * HALF + m * 16) * ldc + col0;
#pragma unroll
                for (int bj = 0; bj < 2; ++bj) { const f32x4 v0 = acc[ai][bj][m][0], v1 = acc[ai][bj][m][1];
                    const u32x4 mw = *(const u32x4*)(Mg + off + bj * HALF);
                    u32x4 w;
                    if (MODE == 0) {
                        w.x = cvt_pk_bf16(bf_lo(mw.x) * v0[0], bf_hi(mw.x) * v0[1]); w.y = cvt_pk_bf16(bf_lo(mw.y) * v0[2], bf_hi(mw.y) * v0[3]);
                        w.z = cvt_pk_bf16(bf_lo(mw.z) * v1[0], bf_hi(mw.z) * v1[1]); w.w = cvt_pk_bf16(bf_lo(mw.w) * v1[2], bf_hi(mw.w) * v1[3]);
                    } else {
                        const u32x4 sw = *(const u32x4*)(Sg + off + bj * HALF);
                        w.x = cvt_pk_bf16(bf_lo(mw.x) + bf_lo(sw.x) * v0[0], bf_hi(mw.x) + bf_hi(sw.x) * v0[1]); w.y = cvt_pk_bf16(bf_lo(mw.y) + bf_lo(sw.y) * v0[2], bf_hi(mw.y) + bf_hi(sw.y) * v0[3]);
                        w.z = cvt_pk_bf16(bf_lo(mw.z) + bf_lo(sw.z) * v1[0], bf_hi(mw.z) + bf_hi(sw.z) * v1[1]); w.w = cvt_pk_bf16(bf_lo(mw.w) + bf_lo(sw.w) * v1[2], bf_hi(mw.w) + bf_hi(sw.w) * v1[3]);
                    }
                    *(u32x4*)(Mg + off + bj * HALF) = w; }
                if (m & 1) asm volatile("" ::: "memory"); }
    }
};
template <bool SQ> struct EpiRes {
    static constexpr bool PERM = false;
    const float* base; float* out; int ldc; bf16_t* xb; float* sumsq; bf16_t* rb;
    __device__ __forceinline__ void operator()(AccRef acc, const Unit& u, int wr, int wc, int fr, int fq) const {
        const int row0 = u.pm * BM + wr * 64 + fr, col0 = u.pn * BM + wc * 32 + 4 * fq;
#pragma unroll
        for (int ai = 0; ai < 2; ++ai)
#pragma unroll
            for (int m = 0; m < 4; ++m) { const int row = row0 + ai * HALF + m * 16; const size_t off = (size_t)row * ldc + col0; float ss = 0.f;
#pragma unroll
                for (int bj = 0; bj < 2; ++bj)
#pragma unroll
                    for (int n = 0; n < 2; ++n) {
                        if (SQ) { f32x4 b; if (rb) { const u32x2 rw = *(const u32x2*)(rb + off + bj * HALF + n * 16); b[0] = bf_lo(rw.x); b[1] = bf_hi(rw.x); b[2] = bf_lo(rw.y); b[3] = bf_hi(rw.y); } else b = *(const f32x4*)(base + off + bj * HALF + n * 16);
                            const f32x4 v = b + acc[ai][bj][m][n];
                            ss += (v[0] * v[0] + v[1] * v[1]) + (v[2] * v[2] + v[3] * v[3]); u32x2 w; w.x = cvt_pk_bf16(v[0], v[1]); w.y = cvt_pk_bf16(v[2], v[3]); *(u32x2*)(xb + off + bj * HALF + n * 16) = w; }
                        else { const u32x2 bw = *(const u32x2*)(xb + off + bj * HALF + n * 16); const f32x4 a4 = acc[ai][bj][m][n];
                            f32x4 v; v[0] = bf_lo(bw.x) + a4[0]; v[1] = bf_hi(bw.x) + a4[1]; v[2] = bf_lo(bw.y) + a4[2]; v[3] = bf_hi(bw.y) + a4[3];
                            if (rb) { u32x2 w; w.x = cvt_pk_bf16(v[0], v[1]); w.y = cvt_pk_bf16(v[2], v[3]); *(u32x2*)(rb + off + bj * HALF + n * 16) = w; } else *(f32x4*)(out + off + bj * HALF + n * 16) = v; } }
                if (SQ) { ss += __shfl_xor(ss, 16); ss += __shfl_xor(ss, 32); if (fq == 0) __hip_atomic_fetch_add(sumsq + row, ss, __ATOMIC_RELAXED, __HIP_MEMORY_SCOPE_AGENT); }
                if (m & 1) asm volatile("" ::: "memory"); }
    }
};

template <class Epi>
__device__ __forceinline__ void gemm_phase(LAS unsigned char* lds, const Gemm g, const StaticOrder& S, const Epi& E, const int tid) {
    const int wid = __builtin_amdgcn_readfirstlane(tid >> 6), lane = tid & 63, wr = wid >> 2, wc = wid & 3, fr = lane & 15, fq = lane >> 4;
    const int K = g.K, nt = K / BK;
    unsigned voffA[2], voffB[2];
#pragma unroll
    for (int i = 0; i < 2; ++i) { int R, C; stage_rc(tid * 16 + i * 8192, R, C); const int Rb = Epi::PERM ? ((R & ~31) + perm32(R & 31)) : R;
        voffA[i] = (unsigned)(R * g.lda + C) * 2u; voffB[i] = (unsigned)(Rb * K + C) * 2u; }
    const size_t kstep = (size_t)(BK * 2);
    const size_t hstepA = (size_t)HALF * g.lda * 2, hstepB = (size_t)HALF * K * 2;
    const size_t tstepA = 2 * hstepA, tstepB = 2 * hstepB;
    const unsigned ldsw = (unsigned)wid * 1024u;
    const int aoff = lds_byte(wr * 64 + fr, fq * 8), boff = lds_byte(wc * 32 + fr, fq * 8);
#define PG8_SA(b, h) (((b) * 2 + (h)) * HTB)
#define PG8_SB(b, h) ((4 + (b) * 2 + (h)) * HTB)
#define PG8_STAGE(bufoff, gbase, voff) do { _Pragma("unroll") for (int _i = 0; _i < 2; ++_i) \
        __builtin_amdgcn_global_load_lds((const unsigned*)((const char*)(gbase) + (voff)[_i]), (LAS unsigned*)(lds + (bufoff) + ldsw + _i * 8192), 16, 0, 0); } while (0)
#define PG8_LDA(dst, b, h) do { _Pragma("unroll") for (int m = 0; m < 4; ++m) _Pragma("unroll") for (int k = 0; k < 2; ++k) dst[m][k] = *(const LAS bf16x8*)(lds + PG8_SA(b, h) + aoff + m * 2048 + k * 1024); } while (0)
#define PG8_LDB(dst, b, h) do { _Pragma("unroll") for (int n = 0; n < 2; ++n) _Pragma("unroll") for (int k = 0; k < 2; ++k) dst[n][k] = *(const LAS bf16x8*)(lds + PG8_SB(b, h) + boff + n * 2048 + k * 1024); } while (0)
#define PG8_MMA(ai, bj, At, Bt) do { __builtin_amdgcn_s_setprio(1); _Pragma("unroll") for (int m = 0; m < 4; ++m) _Pragma("unroll") for (int n = 0; n < 2; ++n) _Pragma("unroll") for (int k = 0; k < 2; ++k) \
        acc[ai][bj][m][n] = __builtin_amdgcn_mfma_f32_16x16x32_bf16(Bt[n][k], At[m][k], acc[ai][bj][m][n], 0, 0, 0); __builtin_amdgcn_s_setprio(0); } while (0)
#define PG8_WAIT_V(n) asm volatile("s_waitcnt vmcnt(" #n ")" ::: "memory")
#define PG8_WAIT_L(n) asm volatile("s_waitcnt lgkmcnt(" #n ")" ::: "memory")
#define PG8_BAR __builtin_amdgcn_s_barrier()
#define PG8_SCHED __builtin_amdgcn_sched_barrier(0)
    Unit cur, nxt; int ui = 0;
    if (!S.next(0, cur)) return;
    f32x4 acc[2][2][4][2];
#pragma unroll
    for (int a = 0; a < 2; ++a)
#pragma unroll
        for (int b = 0; b < 2; ++b)
#pragma unroll
            for (int m = 0; m < 4; ++m)
#pragma unroll
                for (int n = 0; n < 2; ++n) acc[a][b][m][n] = (f32x4){0.f, 0.f, 0.f, 0.f};
    bf16x8 At[4][2], B0[2][2], B1[2][2];
    const char* cA = (const char*)g.A + (size_t)cur.pm * tstepA; const char* cB = (const char*)g.Bt + (size_t)cur.pn * tstepB;
    PG8_STAGE(PG8_SB(0, 0), cB, voffB); PG8_STAGE(PG8_SB(0, 1), cB + hstepB, voffB); PG8_STAGE(PG8_SA(0, 0), cA, voffA); PG8_STAGE(PG8_SA(0, 1), cA + hstepA, voffA);
    if (wr == 1) PG8_BAR;
    PG8_WAIT_V(2); PG8_BAR;
    PG8_STAGE(PG8_SB(1, 0), cB + kstep, voffB); PG8_STAGE(PG8_SA(1, 0), cA + kstep, voffA); PG8_STAGE(PG8_SB(1, 1), cB + hstepB + kstep, voffB);
    PG8_WAIT_V(6); PG8_BAR;
    for (;;) {
        const bool has_next = S.next(ui + 1, nxt);
        const char* nA = has_next ? (const char*)g.A + (size_t)nxt.pm * tstepA : cA; const char* nB = has_next ? (const char*)g.Bt + (size_t)nxt.pn * tstepB : cB;
        for (int t = 0; t < nt; t += 2) {
            const bool last = (t == nt - 2);
            const char* a1 = cA + (size_t)(t + 1) * kstep;
            const char* a2 = last ? nA : cA + (size_t)(t + 2) * kstep; const char* b2 = last ? nB : cB + (size_t)(t + 2) * kstep;
            const char* a3 = a2 + kstep; const char* b3 = b2 + kstep;
            PG8_LDB(B0, 0, 0); PG8_LDB(B1, 0, 1); PG8_SCHED; PG8_LDA(At, 0, 0); PG8_STAGE(PG8_SA(1, 1), a1 + hstepA, voffA);
            PG8_WAIT_V(8); PG8_WAIT_L(0); PG8_BAR; PG8_MMA(0, 0, At, B0); PG8_MMA(0, 1, At, B1); PG8_BAR; PG8_SCHED;
            PG8_LDA(At, 0, 1); PG8_STAGE(PG8_SB(0, 0), b2, voffB); PG8_STAGE(PG8_SB(0, 1), b2 + hstepB, voffB); PG8_STAGE(PG8_SA(0, 0), a2, voffA);
            PG8_WAIT_V(8); PG8_WAIT_L(0); PG8_BAR; PG8_MMA(1, 0, At, B0); PG8_MMA(1, 1, At, B1); PG8_BAR; PG8_SCHED;
            PG8_LDB(B0, 1, 0); PG8_LDB(B1, 1, 1); PG8_SCHED; PG8_LDA(At, 1, 0); PG8_STAGE(PG8_SA(0, 1), a2 + hstepA, voffA);
            PG8_WAIT_V(8); PG8_WAIT_L(0); PG8_BAR; PG8_MMA(0, 0, At, B0); PG8_MMA(0, 1, At, B1); PG8_BAR; PG8_SCHED;
            PG8_LDA(At, 1, 1); PG8_STAGE(PG8_SB(1, 0), b3, voffB); PG8_STAGE(PG8_SB(1, 1), b3 + hstepB, voffB); PG8_STAGE(PG8_SA(1, 0), a3, voffA);
            PG8_WAIT_V(8); PG8_WAIT_L(0); PG8_BAR; PG8_MMA(1, 0, At, B0); PG8_MMA(1, 1, At, B1); PG8_BAR; PG8_SCHED;
        }
        if (wr == 0) PG8_BAR;
        E(acc, cur, wr, wc, fr, fq);
        if (!has_next) break;
#pragma unroll
        for (int a = 0; a < 2; ++a)
#pragma unroll
            for (int b = 0; b < 2; ++b)
#pragma unroll
                for (int m = 0; m < 4; ++m)
#pragma unroll
                    for (int n = 0; n < 2; ++n) acc[a][b][m][n] = (f32x4){0.f, 0.f, 0.f, 0.f};
        cur = nxt; cA = nA; cB = nB; ++ui;
        if (wr == 1) PG8_BAR;
    }
    PG8_WAIT_V(0);
    PG8_BAR;
#undef PG8_SA
#undef PG8_SB
#undef PG8_STAGE
#undef PG8_LDA
#undef PG8_LDB
#undef PG8_MMA
#undef PG8_WAIT_V
#undef PG8_WAIT_L
#undef PG8_BAR
#undef PG8_SCHED
}
}

struct Ctx { unsigned char* lds; int tid, lane, wave, bid, G; };
__device__ __forceinline__ Ctx make_ctx(unsigned char* lds) { int tid = threadIdx.x; asm volatile("" : "+v"(tid)); Ctx c; c.lds = lds; c.tid = tid; c.lane = tid & 63; c.wave = __builtin_amdgcn_readfirstlane(tid >> 6); c.bid = blockIdx.x; c.G = gridDim.x; return c; }

__device__ __forceinline__ void transpose_item(const float* W, int K, int N, bf16_t* WT, float* scr, int item, int lane, const float* kscale = nullptr) {
    const int nblk = N / 32, kb = item / nblk, nb = item % nblk, k0 = 64 * kb, n0 = 32 * nb;
#pragma unroll 8
    for (int i = 0; i < 32; ++i) { const int kk = 2 * i + (lane >> 5); scr[kk * 33 + (lane & 31)] = W[(size_t)(k0 + kk) * N + n0 + (lane & 31)] * (kscale ? kscale[k0 + kk] : 1.f); }
    asm volatile("s_waitcnt lgkmcnt(0)" ::: "memory");
    const int c = lane & 7;
#pragma unroll
    for (int j = 0; j < 4; ++j) { const int n = (lane >> 3) + 8 * j; const float* s = scr + (8 * c) * 33 + n;
        u32x4 o; o.x = cvt_pk_bf16(s[0 * 33], s[1 * 33]); o.y = cvt_pk_bf16(s[2 * 33], s[3 * 33]); o.z = cvt_pk_bf16(s[4 * 33], s[5 * 33]); o.w = cvt_pk_bf16(s[6 * 33], s[7 * 33]);
        *(u32x4*)(WT + (size_t)(n0 + n) * K + k0 + 8 * c) = o; }
    asm volatile("s_waitcnt lgkmcnt(0)" ::: "memory");
}

__device__ __forceinline__ void rms_rows_bf16(const Ctx& c, const float* src, const float* w, bf16_t* dst, int ldo) {
    const int gw = c.bid * 8 + c.wave, NGW = c.G * 8;
    f32x4 wv[4];
#pragma unroll
    for (int j = 0; j < 4; ++j) wv[j] = *((const f32x4*)w + c.lane + 64 * j);
    for (int m = gw; m < T; m += NGW) {
        const f32x4* xr = (const f32x4*)(src + (size_t)m * D) + c.lane;
        f32x4 v[4]; float s = 0.f;
#pragma unroll
        for (int j = 0; j < 4; ++j) { v[j] = xr[64 * j]; s += (v[j].x * v[j].x + v[j].y * v[j].y) + (v[j].z * v[j].z + v[j].w * v[j].w); }
        const float rstd = rsqrtf(wave_sum(s) * (1.f / D) + EPS);
        u32x2* o8 = (u32x2*)(dst + (size_t)m * ldo) + c.lane;
#pragma unroll
        for (int j = 0; j < 4; ++j) { u32x2 o; o.x = cvt_pk_bf16(v[j].x * rstd * wv[j].x, v[j].y * rstd * wv[j].y); o.y = cvt_pk_bf16(v[j].z * rstd * wv[j].z, v[j].w * rstd * wv[j].w); o8[64 * j] = o; }
    }
}
__device__ __forceinline__ void rms_rows_bf16_src(const Ctx& c, const bf16_t* src, const float* w, bf16_t* dst, int ldo) {
    const int gw = c.bid * 8 + c.wave, NGW = c.G * 8;
    f32x4 wv[4];
#pragma unroll
    for (int j = 0; j < 4; ++j) wv[j] = *((const f32x4*)w + c.lane + 64 * j);
    for (int m = gw; m < T; m += NGW) {
        const u32x2* xr = (const u32x2*)(src + (size_t)m * D) + c.lane;
        f32x4 v[4]; float s = 0.f;
#pragma unroll
        for (int j = 0; j < 4; ++j) { const u32x2 r = xr[64 * j]; v[j].x = bf_lo(r.x); v[j].y = bf_hi(r.x); v[j].z = bf_lo(r.y); v[j].w = bf_hi(r.y); s += (v[j].x * v[j].x + v[j].y * v[j].y) + (v[j].z * v[j].z + v[j].w * v[j].w); }
        const float rstd = rsqrtf(wave_sum(s) * (1.f / D) + EPS);
        u32x2* o8 = (u32x2*)(dst + (size_t)m * ldo) + c.lane;
#pragma unroll
        for (int j = 0; j < 4; ++j) { u32x2 o; o.x = cvt_pk_bf16(v[j].x * rstd * wv[j].x, v[j].y * rstd * wv[j].y); o.y = cvt_pk_bf16(v[j].z * rstd * wv[j].z, v[j].w * rstd * wv[j].w); o8[64 * j] = o; }
    }
}
__device__ __forceinline__ void rms_rows_f32_inplace(const Ctx& c, float* x, const float* w) {
    const int gw = c.bid * 8 + c.wave, NGW = c.G * 8;
    f32x4 wv[4];
#pragma unroll
    for (int j = 0; j < 4; ++j) wv[j] = *((const f32x4*)w + c.lane + 64 * j);
    for (int m = gw; m < T; m += NGW) {
        f32x4* xr = (f32x4*)(x + (size_t)m * D) + c.lane;
        f32x4 v[4]; float s = 0.f;
#pragma unroll
        for (int j = 0; j < 4; ++j) { v[j] = xr[64 * j]; s += (v[j].x * v[j].x + v[j].y * v[j].y) + (v[j].z * v[j].z + v[j].w * v[j].w); }
        const float rstd = rsqrtf(wave_sum(s) * (1.f / D) + EPS);
#pragma unroll
        for (int j = 0; j < 4; ++j) xr[64 * j] = v[j] * rstd * wv[j];
    }
}

__device__ __forceinline__ float lower_bound_of(const float* lb_logits, int l, int dir, int col) {
    if (l == 0) return 0.f;
    const float l0 = lb_logits[dir * 512 + col], l1 = lb_logits[1024 + dir * 512 + col];
    return 1.0f / (1.0f + __expf(l0 - l1));
}

__device__ __forceinline__ void phase_pre(const Ctx& c, int l, const float* in1, const float* in2, const float* in3, const float* in5, const float* in8, const float* in9, const float* in10, const float* in11, const float* in12, const float* xsrc, unsigned char* ws) {
    float* scr = (float*)(c.lds + c.wave * 8704);
    const int gw = c.bid * 8 + c.wave, NGW = c.G * 8;
    bf16_t* Wb = (bf16_t*)(ws + WS_W);
    const float* w_in = in1 + (size_t)l * D * DIN; const float* w_br = in8 + (size_t)l * 3 * 512 * D; const float* w_out = in9 + (size_t)l * D * D;
    const float* w_up = in11 + (size_t)l * D * DFF; const float* w_dn = in12 + (size_t)l * DFF * D;
    constexpr int I_IN = (D / 64) * (DIN / 32), I_BR = (512 / 64) * (D / 32), I_OUT = (D / 64) * (D / 32), I_UP = (D / 64) * (DFF / 32), I_DN = (DFF / 64) * (D / 32);
    constexpr int NITEMS = I_IN + 3 * I_BR + I_OUT + I_UP + I_DN;
    for (int it = gw; it < NITEMS; it += NGW) {
        int r = it;
        if (r < I_IN) { transpose_item(w_in, D, DIN, (bf16_t*)((char*)Wb + W_IN), scr, r, c.lane); continue; } r -= I_IN;
        if (r < 3 * I_BR) { const int b = r / I_BR; transpose_item(w_br + (size_t)b * 512 * D, 512, D, (bf16_t*)((char*)Wb + W_BR) + (size_t)b * D * 512, scr, r % I_BR, c.lane); continue; } r -= 3 * I_BR;
        if (r < I_OUT) { transpose_item(w_out, D, D, (bf16_t*)((char*)Wb + W_OUT), scr, r, c.lane); continue; } r -= I_OUT;
        if (r < I_UP) { transpose_item(w_up, D, DFF, (bf16_t*)((char*)Wb + W_UP), scr, r, c.lane, in10 + (size_t)l * D); continue; } r -= I_UP;
        transpose_item(w_dn, DFF, D, (bf16_t*)((char*)Wb + W_DN), scr, r, c.lane);
    }
    const int gt = c.bid * 512 + c.tid, NGT = c.G * 512;
    {
        const float* wsrc = in5 + (size_t)l * 4 * 128 * 128; bf16_t* wd = (bf16_t*)(ws + WS_WSB);
        for (int i = gt; i < 4 * 128 * 128; i += NGT) wd[i] = f2bf(wsrc[i]);
    }
    {   float* sq = (float*)(ws + WS_SUMSQ); for (int i = gt; i < T; i += NGT) sq[i] = 0.f; }
    {
        float* low = (float*)(ws + WS_LOW);
        for (int i = gt; i < 1024; i += NGT) low[i] = lower_bound_of(in3, l, i >> 9, i & 511);
    }
    if (l == 0) {
        f32x2* rt = (f32x2*)(ws + WS_ROPE);
        for (int i = gt; i < SEQ * 8; i += NGT) {
            const int pos = i >> 3, j = i & 7;
            const float inv = j == 0 ? 1.0f : j == 1 ? 0.1939227432012558f : j == 2 ? 0.03760603070259094f : j == 3 ? 0.007292664609849453f : j == 4 ? 0.0014142135623842478f : j == 5 ? 0.00027424818836152554f : j == 6 ? 5.318296098266728e-05f : 1.0313386155758053e-05f;
            const float ang = (float)pos * inv;
            const double rev = (double)ang * 0.15915494309189535; const double fr = rev - __builtin_rint(rev);
            const float f = (float)fr;
            rt[i] = (f32x2){__builtin_amdgcn_cosf(f), __builtin_amdgcn_sinf(f)};
        }
    }
    if (l == 0) rms_rows_bf16(c, xsrc, in2 + (size_t)l * D, (bf16_t*)(ws + WS_Z) + ZXN, LDZ);
    else rms_rows_bf16_src(c, (const bf16_t*)xsrc, in2 + (size_t)l * D, (bf16_t*)(ws + WS_Z) + ZXN, LDZ);
}

__device__ __forceinline__ void branch_b_unit(const Ctx& c, bf16_t* Z, const bf16_t* WSB, const float* bs, int unit) {
    constexpr int VP = 136;
    bf16_t* vnT = (bf16_t*)c.lds;
    bf16_t* zrow0 = Z + (size_t)unit * 128 * LDZ;
    const int fr = c.lane & 15, fq = c.lane >> 4;
    {
        const int p = c.wave * 16 + fr;
        const bf16_t* src = zrow0 + (size_t)p * LDZ + ZV + fq * 128;
        u32x4 raw[16]; float s = 0.f;
#pragma unroll
        for (int i = 0; i < 16; ++i) { raw[i] = *(const u32x4*)(src + i * 8);
            s += (bf_lo(raw[i].x) + bf_hi(raw[i].x)) + (bf_lo(raw[i].y) + bf_hi(raw[i].y)) + (bf_lo(raw[i].z) + bf_hi(raw[i].z)) + (bf_lo(raw[i].w) + bf_hi(raw[i].w)); }
        s += __shfl_xor(s, 16); s += __shfl_xor(s, 32);
        const float mean = s * (1.f / 512.f); float q = 0.f;
#pragma unroll
        for (int i = 0; i < 16; ++i) {
            float d;
            d = bf_lo(raw[i].x) - mean; q += d * d; d = bf_hi(raw[i].x) - mean; q += d * d; d = bf_lo(raw[i].y) - mean; q += d * d; d = bf_hi(raw[i].y) - mean; q += d * d;
            d = bf_lo(raw[i].z) - mean; q += d * d; d = bf_hi(raw[i].z) - mean; q += d * d; d = bf_lo(raw[i].w) - mean; q += d * d; d = bf_hi(raw[i].w) - mean; q += d * d; }
        q += __shfl_xor(q, 16); q += __shfl_xor(q, 32);
        const float rstd = rsqrtf(q * (1.f / 512.f) + EPS);
        bf16_t* dst = vnT + (size_t)(fq * 128) * VP + p;
#pragma unroll
        for (int i = 0; i < 16; ++i) {
            dst[(i * 8 + 0) * VP] = f2bf((bf_lo(raw[i].x) - mean) * rstd); dst[(i * 8 + 1) * VP] = f2bf((bf_hi(raw[i].x) - mean) * rstd);
            dst[(i * 8 + 2) * VP] = f2bf((bf_lo(raw[i].y) - mean) * rstd); dst[(i * 8 + 3) * VP] = f2bf((bf_hi(raw[i].y) - mean) * rstd);
            dst[(i * 8 + 4) * VP] = f2bf((bf_lo(raw[i].z) - mean) * rstd); dst[(i * 8 + 5) * VP] = f2bf((bf_hi(raw[i].z) - mean) * rstd);
            dst[(i * 8 + 6) * VP] = f2bf((bf_lo(raw[i].w) - mean) * rstd); dst[(i * 8 + 7) * VP] = f2bf((bf_hi(raw[i].w) - mean) * rstd); }
    }
    __syncthreads();
    const int q = c.wave * 16 + fr;
#pragma unroll 1
    for (int g = 0; g < 4; ++g) {
        bf16x8 wf[4];
#pragma unroll
        for (int kk = 0; kk < 4; ++kk) wf[kk] = *(const bf16x8*)(WSB + (size_t)(g * 128 + q) * 128 + kk * 32 + fq * 8);
        const float bias = bs[g * 128 + q];
        bf16_t* ub = zrow0 + (size_t)q * LDZ + ZU + g * 128 + fq * 4;
        u32x2 uu[8];
#pragma unroll
        for (int ct = 0; ct < 8; ++ct) uu[ct] = *(const u32x2*)(ub + ct * 16);
#pragma unroll
        for (int ct = 0; ct < 8; ++ct) {
            f32x4 acc = (f32x4){0.f, 0.f, 0.f, 0.f};
#pragma unroll
            for (int kk = 0; kk < 4; ++kk) { const bf16x8 a = *(const bf16x8*)(vnT + (size_t)(g * 128 + ct * 16 + fr) * VP + kk * 32 + fq * 8); acc = __builtin_amdgcn_mfma_f32_16x16x32_bf16(a, wf[kk], acc, 0, 0, 0); }
            u32x2 o; o.x = cvt_pk_bf16(bf_lo(uu[ct].x) * (acc[0] + bias), bf_hi(uu[ct].x) * (acc[1] + bias)); o.y = cvt_pk_bf16(bf_lo(uu[ct].y) * (acc[2] + bias), bf_hi(uu[ct].y) * (acc[3] + bias));
            *(u32x2*)(ub + ct * 16) = o;
        }
    }
    __syncthreads();
}

__device__ __forceinline__ void branch_c_unit(const Ctx& c, bf16_t* Z, const float* sink, int unit) {
    constexpr int KP = 72, VTP = 408;
    bf16_t* Ks = (bf16_t*)c.lds;
    bf16_t* Vt = (bf16_t*)(c.lds + 400 * KP * 2);
    const int hk = unit & 1, n = (unit >> 1) & 63, b = unit >> 7;
    const int fr = c.lane & 15, fq = c.lane >> 4;
    const size_t rowb = (size_t)b * SEQ;
    const int g = c.wave >> 1, half = c.wave & 1, head = hk * 4 + g;
    bf16_t* qrow0 = Z + (rowb + n * 128 + half * 64 + fr) * LDZ + ZCQ + head * 64;
    u32x4 qa[4], qb[4];
#pragma unroll
    for (int qt = 0; qt < 4; ++qt) { qa[qt] = *(const u32x4*)(qrow0 + (size_t)qt * 16 * LDZ + fq * 8); qb[qt] = *(const u32x4*)(qrow0 + (size_t)qt * 16 * LDZ + 32 + fq * 8); }
    {
        u32x4 kv[7], vv[7];
#pragma unroll
        for (int it = 0; it < 7; ++it) {
            const int chunk = c.tid + 512 * it; const int row = chunk >> 3, part = chunk & 7;
            const int tk = (n - 1) * 128 + row;
            const bool valid = row < 384 && tk >= 0 && tk < SEQ;
            kv[it] = (u32x4){0u, 0u, 0u, 0u}; vv[it] = (u32x4){0u, 0u, 0u, 0u};
            if (valid) { const bf16_t* zr = Z + (rowb + tk) * LDZ; kv[it] = *(const u32x4*)(zr + ZCK + hk * 64 + part * 8); vv[it] = *(const u32x4*)(zr + ZCV + hk * 64 + part * 8); }
        }
#pragma unroll
        for (int it = 0; it < 7; ++it) {
            const int chunk = c.tid + 512 * it; const int row = chunk >> 3, part = chunk & 7;
            if (row < 400) {
                *(u32x4*)(Ks + row * KP + part * 8) = kv[it];
                bf16_t* vd = Vt + (part * 8) * VTP + row;
                vd[0 * VTP] = (bf16_t)(vv[it].x & 0xffffu); vd[1 * VTP] = (bf16_t)(vv[it].x >> 16); vd[2 * VTP] = (bf16_t)(vv[it].y & 0xffffu); vd[3 * VTP] = (bf16_t)(vv[it].y >> 16);
                vd[4 * VTP] = (bf16_t)(vv[it].z & 0xffffu); vd[5 * VTP] = (bf16_t)(vv[it].z >> 16); vd[6 * VTP] = (bf16_t)(vv[it].w & 0xffffu); vd[7 * VTP] = (bf16_t)(vv[it].w >> 16);
            }
        }
    }
    __syncthreads();
    const float sk = sink[head];
    const int base = fq * 4 - fr;
#pragma unroll
    for (int qt = 0; qt < 4; ++qt) {
        const int q0 = half * 64 + qt * 16;
        const bf16x8 qf0 = __builtin_bit_cast(bf16x8, qa[qt]), qf1 = __builtin_bit_cast(bf16x8, qb[qt]);
        const int kt0 = q0 >> 4;
        f32x4 s[17]; float mx = sk;
#pragma unroll
        for (int tt = 0; tt < 17; ++tt) {
            const int kt = kt0 + tt;
            const bool tile_ok = !((n == 0 && kt < 8) || (n == 63 && kt >= 16));
            f32x4 a = (f32x4){-1e30f, -1e30f, -1e30f, -1e30f};
            if (tile_ok) {
                const bf16_t* kr = Ks + (kt * 16 + fr) * KP + fq * 8;
                a = (f32x4){0.f, 0.f, 0.f, 0.f};
                a = __builtin_amdgcn_mfma_f32_16x16x32_bf16(*(const bf16x8*)kr, qf0, a, 0, 0, 0);
                a = __builtin_amdgcn_mfma_f32_16x16x32_bf16(*(const bf16x8*)(kr + 32), qf1, a, 0, 0, 0);
#pragma unroll
                for (int j = 0; j < 4; ++j) {
                    float v = a[j] * 0.125f;
                    if (tt == 0) v = (base + j >= 0) ? v : -1e30f;
                    if (tt == 16) v = (base + j <= 0) ? v : -1e30f;
                    a[j] = v; mx = fmaxf(mx, v);
                }
            }
            s[tt] = a;
        }
        mx = fmaxf(mx, __shfl_xor(mx, 16)); mx = fmaxf(mx, __shfl_xor(mx, 32));
        float lsum = 0.f;
#pragma unroll
        for (int tt = 0; tt < 17; ++tt)
#pragma unroll
            for (int j = 0; j < 4; ++j) { const float p = __expf(s[tt][j] - mx); s[tt][j] = p; lsum += p; }
        lsum += __shfl_xor(lsum, 16); lsum += __shfl_xor(lsum, 32);
        lsum += __expf(sk - mx);
        const float rl = __builtin_amdgcn_rcpf(lsum);
        f32x4 o[4];
#pragma unroll
        for (int dt = 0; dt < 4; ++dt) o[dt] = (f32x4){0.f, 0.f, 0.f, 0.f};
#pragma unroll
        for (int kk = 0; kk < 9; ++kk) {
            u32x4 pw; pw.x = cvt_pk_bf16(s[2 * kk][0], s[2 * kk][1]); pw.y = cvt_pk_bf16(s[2 * kk][2], s[2 * kk][3]);
            if (kk < 8) { pw.z = cvt_pk_bf16(s[2 * kk + 1][0], s[2 * kk + 1][1]); pw.w = cvt_pk_bf16(s[2 * kk + 1][2], s[2 * kk + 1][3]); } else { pw.z = 0u; pw.w = 0u; }
            const bf16x8 pf = __builtin_bit_cast(bf16x8, pw);
#pragma unroll
            for (int dt = 0; dt < 4; ++dt) {
                const bf16_t* vr = Vt + (dt * 16 + fr) * VTP + (kt0 + 2 * kk) * 16 + fq * 4;
                u32x4 vw; const u32x2 v0 = *(const u32x2*)vr, v1 = *(const u32x2*)(vr + 16); vw.x = v0.x; vw.y = v0.y; vw.z = v1.x; vw.w = v1.y;
                o[dt] = __builtin_amdgcn_mfma_f32_16x16x32_bf16(__builtin_bit_cast(bf16x8, vw), pf, o[dt], 0, 0, 0);
            }
        }
        bf16_t* qrow = qrow0 + (size_t)qt * 16 * LDZ;
#pragma unroll
        for (int dt = 0; dt < 4; ++dt) { u32x2 w; w.x = cvt_pk_bf16(o[dt][0] * rl, o[dt][1] * rl); w.y = cvt_pk_bf16(o[dt][2] * rl, o[dt][3] * rl); *(u32x2*)(qrow + dt * 16 + fq * 4) = w; }
    }
    __syncthreads();
}

__device__ __forceinline__ void stage_tile64x128(bf16_t* dst  , const bf16_t* src  , int tid) {
#pragma unroll
    for (int i = 0; i < 2; ++i) { const int chunk = tid + 512 * i; const int s = chunk >> 4, part = chunk & 15;
        *(u32x4*)(dst + s * 136 + part * 8) = *(const u32x4*)(src + (size_t)s * LDZ + part * 8); }
}
__device__ __forceinline__ void stage_vt(bf16_t* Vt  , const bf16_t* src, int tid) {
    constexpr int SP = 72;
#pragma unroll
    for (int i = 0; i < 2; ++i) { const int chunk = tid + 512 * i; const int s = chunk >> 4, part = chunk & 15;
        const u32x4 vv = *(const u32x4*)(src + (size_t)s * LDZ + part * 8);
        bf16_t* vd = Vt + (part * 8) * SP + (s ^ ((part & 7) << 3));
        vd[0 * SP] = (bf16_t)(vv.x & 0xffffu); vd[1 * SP] = (bf16_t)(vv.x >> 16); vd[2 * SP] = (bf16_t)(vv.y & 0xffffu); vd[3 * SP] = (bf16_t)(vv.y >> 16);
        vd[4 * SP] = (bf16_t)(vv.z & 0xffffu); vd[5 * SP] = (bf16_t)(vv.z >> 16); vd[6 * SP] = (bf16_t)(vv.w & 0xffffu); vd[7 * SP] = (bf16_t)(vv.w >> 16); }
}
__device__ __forceinline__ float gate_cumsum(float (&gl)[32], float (&ky)[32], int dir) {
#pragma unroll
    for (int i = 0; i < 32; ++i) ky[i] = 1.0f - __expf(gl[i]);
    float run = 0.f;
    if (dir == 0) {
#pragma unroll
        for (int i = 0; i < 32; ++i) { run += gl[i]; gl[i] = run; }
    } else {
#pragma unroll
        for (int i = 31; i >= 0; --i) { run += gl[i]; gl[i] = run; }
    }
    return run;
}
__device__ __forceinline__ void hgrn_pass1_unit(const Ctx& c, const bf16_t* Z, bf16_t* Lg, float* DEC, float* ENR, int unit) {
    constexpr int SP = 72, QP = 136;
    bf16_t* Raw = (bf16_t*)c.lds;
    bf16_t* KdT = (bf16_t*)c.lds;
    bf16_t* Vt = (bf16_t*)(c.lds + 2 * 128 * SP * 2);
    float* tot = (float*)(c.lds + 3 * 128 * SP * 2);
    const int ch = unit & 127, h = (unit >> 7) & 3, b = unit >> 9;
    const size_t row0 = (size_t)b * SEQ + (size_t)ch * 64;
    const int dir = c.tid >> 8, half = (c.tid >> 7) & 1, k = c.tid & 127;
    const bf16_t* zt = Z + row0 * LDZ + h * 128;
    stage_tile64x128(Raw, zt + ZFF, c.tid); stage_tile64x128(Raw + 64 * QP, zt + ZFB, c.tid); stage_vt(Vt, zt + ZI, c.tid);
    __syncthreads();
    float gl[32], ky[32];
    {
        const bf16_t* zr = Raw + (dir * 64 + half * 32) * QP + k;
#pragma unroll
        for (int i = 0; i < 32; ++i) gl[i] = bf2f(zr[i * QP]);
    }
    const float run = gate_cumsum(gl, ky, dir);
    tot[(dir * 2 + half) * 128 + k] = run;
    __syncthreads();
    const bool near = (half == dir);
    const float tother = tot[(dir * 2 + (half ^ 1)) * 128 + k];
    const float add = run + (near ? tother : 0.f);
    if (near) { const size_t di = ((size_t)((dir * 16 + b * 4 + h) * 128 + (dir ? 127 - ch : ch))) * 128 + k; DEC[di] = __expf(run + tother); ENR[di] = __expf(run); }
    {
        unsigned pkd[16];
#pragma unroll
        for (int i = 0; i < 32; i += 2) pkd[i >> 1] = cvt_pk_bf16(ky[i] * __expf(add - gl[i]), ky[i + 1] * __expf(add - gl[i + 1]));
        u32x4* dst = (u32x4*)(KdT + (dir * 128 + k) * SP + half * 32);
#pragma unroll
        for (int w = 0; w < 4; ++w) dst[w] = (u32x4){pkd[4 * w], pkd[4 * w + 1], pkd[4 * w + 2], pkd[4 * w + 3]};
    }
    __syncthreads();
    {
        const int fr = c.lane & 15, fq = c.lane >> 4;
        const int wd = c.wave >> 2, kq = c.wave & 3;
        bf16_t* Lo = Lg + ((size_t)((wd * 16 + b * 4 + h) * 128 + (wd ? 127 - ch : ch))) * 128 * 128;
#pragma unroll
        for (int kt = 0; kt < 2; ++kt) {
            const bf16_t* ar = KdT + (wd * 128 + kq * 32 + kt * 16 + fr) * SP + fq * 8;
            const bf16x8 a0 = *(const bf16x8*)ar, a1 = *(const bf16x8*)(ar + 32);
#pragma unroll
            for (int vt = 0; vt < 8; ++vt) {
                const int vx = (((vt * 16 + fr) >> 3) & 7) << 3;
                const bf16_t* br = Vt + (vt * 16 + fr) * SP;
                f32x4 acc = (f32x4){0.f, 0.f, 0.f, 0.f};
                acc = __builtin_amdgcn_mfma_f32_16x16x32_bf16(a0, *(const bf16x8*)(br + ((fq * 8) ^ vx)), acc, 0, 0, 0);
                acc = __builtin_amdgcn_mfma_f32_16x16x32_bf16(a1, *(const bf16x8*)(br + ((fq * 8 + 32) ^ vx)), acc, 0, 0, 0);
                u32x2 w; w.x = cvt_pk_bf16(acc[0], acc[1]); w.y = cvt_pk_bf16(acc[2], acc[3]);
                *(u32x2*)(Lo + (size_t)(vt * 16 + fr) * 128 + kq * 32 + kt * 16 + fq * 4) = w;
            }
        }
    }
    __syncthreads();
}

__device__ __forceinline__ void hgrn_scan(const Ctx& c, bf16_t* Lg, const float* DEC, const float* ENR) {
    for (int idx = c.bid * 512 + c.tid; idx < 32 * 128 * 32; idx += c.G * 512) {
        const int k4 = idx & 31, v = (idx >> 5) & 127, seq = idx >> 12;
        bf16_t* lp = Lg + (size_t)seq * 128 * 16384 + (size_t)v * 128 + k4 * 4;
        const float* dp = DEC + (size_t)seq * 128 * 128 + k4 * 4;
        const float* ep = ENR + (size_t)seq * 128 * 128 + k4 * 4;
        f32x4 st = (f32x4){0.f, 0.f, 0.f, 0.f};
#pragma unroll 1
        for (int c0 = 0; c0 < 128; c0 += 8) {
            u32x2 lw[8]; f32x4 dd[8], ee[8];
#pragma unroll
            for (int i = 0; i < 8; ++i) { lw[i] = *(const u32x2*)(lp + (size_t)(c0 + i) * 16384); dd[i] = *(const f32x4*)(dp + (size_t)(c0 + i) * 128); ee[i] = *(const f32x4*)(ep + (size_t)(c0 + i) * 128); }
#pragma unroll
            for (int i = 0; i < 8; ++i) {
                u32x2 o; o.x = cvt_pk_bf16(st[0] * ee[i][0], st[1] * ee[i][1]); o.y = cvt_pk_bf16(st[2] * ee[i][2], st[3] * ee[i][3]);
                *(u32x2*)(lp + (size_t)(c0 + i) * 16384) = o;
                st[0] = dd[i][0] * st[0] + bf_lo(lw[i].x); st[1] = dd[i][1] * st[1] + bf_hi(lw[i].x); st[2] = dd[i][2] * st[2] + bf_lo(lw[i].y); st[3] = dd[i][3] * st[3] + bf_hi(lw[i].y);
            }
        }
    }
}

__device__ __forceinline__ void hgrn_pass3_unit(const Ctx& c, bf16_t* Z, const float* a_norm, const bf16_t* Lg, int unit, int ocol) {
    constexpr int QP = 136, SP = 72;
    bf16_t* Qp = (bf16_t*)c.lds;
    bf16_t* Kp = Qp + 2 * 64 * QP;
    bf16_t* Vt = Kp + 2 * 64 * QP;
    float* tot = (float*)(Vt + 128 * SP);
    float* red = tot + 512;
    const int ch = unit & 127, h = (unit >> 7) & 3, b = unit >> 9;
    const size_t row0 = (size_t)b * SEQ + (size_t)ch * 64;
    {
        const int dir = c.tid >> 8, half = (c.tid >> 7) & 1, k = c.tid & 127;
        const bf16_t* zt = Z + row0 * LDZ + h * 128;
        stage_tile64x128(Qp, zt + ZFF, c.tid); stage_tile64x128(Qp + 64 * QP, zt + ZFB, c.tid); stage_tile64x128(Kp, zt + ZQ, c.tid); stage_vt(Vt, zt + ZI, c.tid);
        __syncthreads();
        float gl[32], ky[32], qv[32];
        {
            const bf16_t* zr = Qp + (dir * 64 + half * 32) * QP + k; const bf16_t* qr = Kp + (half * 32) * QP + k;
#pragma unroll
            for (int i = 0; i < 32; ++i) { gl[i] = bf2f(zr[i * QP]); qv[i] = bf2f(qr[i * QP]); }
        }
        const float run = gate_cumsum(gl, ky, dir);
        __syncthreads();
        const float rsub = (half == dir) ? run : 0.f;
        bf16_t* qpd = Qp + (dir * 64 + half * 32) * QP + k; bf16_t* kpd = Kp + (dir * 64 + half * 32) * QP + k;
#pragma unroll
        for (int i = 0; i < 32; ++i) {
            const float e = __expf(gl[i] - rsub);
            qpd[i * QP] = f2bf(qv[i] * e);
            kpd[i * QP] = f2bf(ky[i] * __builtin_amdgcn_rcpf(e));
        }
    }
    const int fr = c.lane & 15, fq = c.lane >> 4;
    const int tt = c.wave & 3, vh = c.wave >> 2;
    bf16x8 sf[2][4][4];
#pragma unroll
    for (int dir = 0; dir < 2; ++dir) {
        const bf16_t* Sg = Lg + ((size_t)((dir * 16 + b * 4 + h) * 128 + (dir ? 127 - ch : ch))) * 16384;
#pragma unroll
        for (int vt = 0; vt < 4; ++vt)
#pragma unroll
            for (int ks = 0; ks < 4; ++ks) sf[dir][vt][ks] = *(const bf16x8*)(Sg + (size_t)((vh * 4 + vt) * 16 + fr) * 128 + fq * 8 + ks * 32);
    }
    bf16_t* grow = Z + (row0 + tt * 16 + fr) * LDZ + ZG + h * 128;
    u32x2 gwv[4];
#pragma unroll
    for (int vt = 0; vt < 4; ++vt) gwv[vt] = *(const u32x2*)(grow + (vh * 4 + vt) * 16 + fq * 4);
    __syncthreads();
    f32x4 acc[4];
#pragma unroll
    for (int vt = 0; vt < 4; ++vt) acc[vt] = (f32x4){0.f, 0.f, 0.f, 0.f};
#pragma unroll
    for (int dir = 0; dir < 2; ++dir) {
        bf16x8 qf[4];
#pragma unroll
        for (int ks = 0; ks < 4; ++ks) qf[ks] = *(const bf16x8*)(Qp + (size_t)(dir * 64 + tt * 16 + fr) * QP + ks * 32 + fq * 8);
        f32x4 at[4];
#pragma unroll
        for (int st = 0; st < 4; ++st) {
            f32x4 a = (f32x4){0.f, 0.f, 0.f, 0.f};
            const bf16_t* kr = Kp + (size_t)(dir * 64 + st * 16 + fr) * QP + fq * 8;
#pragma unroll
            for (int ks = 0; ks < 4; ++ks) a = __builtin_amdgcn_mfma_f32_16x16x32_bf16(*(const bf16x8*)(kr + ks * 32), qf[ks], a, 0, 0, 0);
#pragma unroll
            for (int j = 0; j < 4; ++j) { const int s = st * 16 + fq * 4 + j, t = tt * 16 + fr; const bool ok = dir ? (s >= t) : (s <= t); a[j] = ok ? a[j] : 0.f; }
            at[st] = a;
        }
#pragma unroll
        for (int kk = 0; kk < 2; ++kk) {
            u32x4 pw; pw.x = cvt_pk_bf16(at[2 * kk][0], at[2 * kk][1]); pw.y = cvt_pk_bf16(at[2 * kk][2], at[2 * kk][3]); pw.z = cvt_pk_bf16(at[2 * kk + 1][0], at[2 * kk + 1][1]); pw.w = cvt_pk_bf16(at[2 * kk + 1][2], at[2 * kk + 1][3]);
            const bf16x8 pf = __builtin_bit_cast(bf16x8, pw);
#pragma unroll
            for (int vt = 0; vt < 4; ++vt) {
                const int vx = ((((vh * 4 + vt) * 16 + fr) >> 3) & 7) << 3, vc = (2 * kk) * 16 + fq * 4; const bf16_t* vrow = Vt + (size_t)((vh * 4 + vt) * 16 + fr) * SP;
                u32x4 vw; const u32x2 v0 = *(const u32x2*)(vrow + (vc ^ vx)), v1 = *(const u32x2*)(vrow + ((vc + 16) ^ vx)); vw.x = v0.x; vw.y = v0.y; vw.z = v1.x; vw.w = v1.y;
                acc[vt] = __builtin_amdgcn_mfma_f32_16x16x32_bf16(__builtin_bit_cast(bf16x8, vw), pf, acc[vt], 0, 0, 0);
            }
        }
        if (A_MASK & 2) {
#pragma unroll
        for (int vt = 0; vt < 4; ++vt)
#pragma unroll
            for (int ks = 0; ks < 4; ++ks) acc[vt] = __builtin_amdgcn_mfma_f32_16x16x32_bf16(sf[dir][vt][ks], qf[ks], acc[vt], 0, 0, 0);
        }
    }
    float ss = 0.f;
#pragma unroll
    for (int vt = 0; vt < 4; ++vt) ss += (acc[vt][0] * acc[vt][0] + acc[vt][1] * acc[vt][1]) + (acc[vt][2] * acc[vt][2] + acc[vt][3] * acc[vt][3]);
    ss += __shfl_xor(ss, 16); ss += __shfl_xor(ss, 32);
    if (fq == 0) red[vh * 64 + tt * 16 + fr] = ss;
    __syncthreads();
    const float rstd = rsqrtf((red[tt * 16 + fr] + red[64 + tt * 16 + fr]) * (1.f / 128.f) + EPS);
#pragma unroll
    for (int vt = 0; vt < 4; ++vt) {
        const int v0 = (vh * 4 + vt) * 16 + fq * 4;
        const u32x2 gw = gwv[vt];
        const f32x4 nw = *(const f32x4*)(a_norm + v0);
        const float g0 = bf_lo(gw.x), g1 = bf_hi(gw.x), g2 = bf_lo(gw.y), g3 = bf_hi(gw.y);
        u32x2 o;
        o.x = cvt_pk_bf16(acc[vt][0] * rstd * nw[0] * g0 * sigmoidf_(g0), acc[vt][1] * rstd * nw[1] * g1 * sigmoidf_(g1));
        o.y = cvt_pk_bf16(acc[vt][2] * rstd * nw[2] * g2 * sigmoidf_(g2), acc[vt][3] * rstd * nw[3] * g3 * sigmoidf_(g3));
        *(u32x2*)(grow + v0 + (ocol - ZG)) = o;
    }
    __syncthreads();
}

__device__ __forceinline__ void p3_issue_raw(unsigned char* lds_raw_, const bf16_t* Z, int unit, int tid, int wave, u32x4 (&vreg)[2]) {
    constexpr int RAWB = 91136;
    const int ch = unit & 127, h = (unit >> 7) & 3, b = unit >> 9;
    const bf16_t* zt = Z + ((size_t)b * SEQ + (size_t)ch * 64) * LDZ + h * 128;
    LAS unsigned char* l3 = (LAS unsigned char*)lds_raw_ + RAWB;
#pragma unroll
    for (int i = 0; i < 2; ++i) { const int chunk = tid + 512 * i; const bf16_t* p = zt + (size_t)(chunk >> 4) * LDZ + (chunk & 15) * 8;
        __builtin_amdgcn_global_load_lds((const unsigned*)(p + ZFF), (LAS unsigned*)(l3 + 0 * 16384 + i * 8192 + wave * 1024), 16, 0, 0);
        __builtin_amdgcn_global_load_lds((const unsigned*)(p + ZFB), (LAS unsigned*)(l3 + 1 * 16384 + i * 8192 + wave * 1024), 16, 0, 0);
        __builtin_amdgcn_global_load_lds((const unsigned*)(p + ZQ),  (LAS unsigned*)(l3 + 2 * 16384 + i * 8192 + wave * 1024), 16, 0, 0);
        vreg[i] = *(const u32x4*)(p + ZI); }
}
#define LDS_BAR() do { asm volatile("s_waitcnt lgkmcnt(0)" ::: "memory"); __builtin_amdgcn_s_barrier(); asm volatile("" ::: "memory"); } while (0)
__device__ __forceinline__ void hgrn_pass3_phase(unsigned char* lds_raw_, bf16_t* Z, const float* a_norm, const bf16_t* Lg, int bid, int G, int ocol) {
    constexpr int QP = 136, SP = 72, RAWB = 91136;
    bf16_t* Qp = (bf16_t*)lds_raw_;
    bf16_t* Kp = Qp + 2 * 64 * QP;
    bf16_t* Vt = Kp + 2 * 64 * QP;
    float* red = (float*)(Vt + 128 * SP) + 512;
    const bf16_t* Raw = (const bf16_t*)(lds_raw_ + RAWB);
    u32x4 vreg[2];
    { const Ctx c0 = make_ctx(lds_raw_); if (bid < 2048) p3_issue_raw(lds_raw_, Z, bid, c0.tid, c0.wave, vreg); }
#pragma unroll 1
    for (int unit = bid; unit < 2048; unit += G) {
        const Ctx c = make_ctx(lds_raw_);
        const int ch = unit & 127, h = (unit >> 7) & 3, b = unit >> 9;
        const size_t row0 = (size_t)b * SEQ + (size_t)ch * 64;
#pragma unroll
        for (int i = 0; i < 2; ++i) { const int chunk = c.tid + 512 * i; const int s = chunk >> 4, part = chunk & 15;
            const u32x4 vv = vreg[i]; bf16_t* vd = Vt + (part * 8) * SP + (s ^ ((part & 7) << 3));
            vd[0 * SP] = (bf16_t)(vv.x & 0xffffu); vd[1 * SP] = (bf16_t)(vv.x >> 16); vd[2 * SP] = (bf16_t)(vv.y & 0xffffu); vd[3 * SP] = (bf16_t)(vv.y >> 16);
            vd[4 * SP] = (bf16_t)(vv.z & 0xffffu); vd[5 * SP] = (bf16_t)(vv.z >> 16); vd[6 * SP] = (bf16_t)(vv.w & 0xffffu); vd[7 * SP] = (bf16_t)(vv.w >> 16); }
        asm volatile("s_waitcnt vmcnt(0)" ::: "memory");
        __syncthreads();
        {
            const int dir = c.tid >> 8, half = (c.tid >> 7) & 1, k = c.tid & 127;
            float gl[32], ky[32], qv[32];
            {
                const bf16_t* zr = Raw + (dir * 64 + half * 32) * 128 + k; const bf16_t* qr = Raw + (128 + half * 32) * 128 + k;
#pragma unroll
                for (int i = 0; i < 32; ++i) { gl[i] = bf2f(zr[i * 128]); qv[i] = bf2f(qr[i * 128]); }
            }
            const float run = gate_cumsum(gl, ky, dir);
            const float rsub = (half == dir) ? run : 0.f;
            bf16_t* qpd = Qp + (dir * 64 + half * 32) * QP + k; bf16_t* kpd = Kp + (dir * 64 + half * 32) * QP + k;
#pragma unroll
            for (int i = 0; i < 32; ++i) {
                const float e = __expf(gl[i] - rsub);
                qpd[i * QP] = f2bf(qv[i] * e);
                kpd[i * QP] = f2bf(ky[i] * __builtin_amdgcn_rcpf(e));
            }
        }
        const int fr = c.lane & 15, fq = c.lane >> 4;
        const int tt = c.wave & 3, vh = c.wave >> 2;
        bf16x8 sf[2][4][4];
#pragma unroll
        for (int dir = 0; dir < 2; ++dir) {
            const bf16_t* Sg = Lg + ((size_t)((dir * 16 + b * 4 + h) * 128 + (dir ? 127 - ch : ch))) * 16384;
#pragma unroll
            for (int vt = 0; vt < 4; ++vt)
#pragma unroll
                for (int ks = 0; ks < 4; ++ks) sf[dir][vt][ks] = *(const bf16x8*)(Sg + (size_t)((vh * 4 + vt) * 16 + fr) * 128 + fq * 8 + ks * 32);
        }
        bf16_t* grow = Z + (row0 + tt * 16 + fr) * LDZ + ZG + h * 128;
        u32x2 gwv[4];
#pragma unroll
        for (int vt = 0; vt < 4; ++vt) gwv[vt] = *(const u32x2*)(grow + (vh * 4 + vt) * 16 + fq * 4);
        LDS_BAR();
        if (unit + G < 2048) p3_issue_raw(lds_raw_, Z, unit + G, c.tid, c.wave, vreg);
        f32x4 acc[4];
#pragma unroll
        for (int vt = 0; vt < 4; ++vt) acc[vt] = (f32x4){0.f, 0.f, 0.f, 0.f};
#pragma unroll
        for (int dir = 0; dir < 2; ++dir) {
            bf16x8 qf[4];
#pragma unroll
            for (int ks = 0; ks < 4; ++ks) qf[ks] = *(const bf16x8*)(Qp + (size_t)(dir * 64 + tt * 16 + fr) * QP + ks * 32 + fq * 8);
            f32x4 at[4];
#pragma unroll
            for (int st = 0; st < 4; ++st) {
                f32x4 a = (f32x4){0.f, 0.f, 0.f, 0.f};
                const bf16_t* kr = Kp + (size_t)(dir * 64 + st * 16 + fr) * QP + fq * 8;
#pragma unroll
                for (int ks = 0; ks < 4; ++ks) a = __builtin_amdgcn_mfma_f32_16x16x32_bf16(*(const bf16x8*)(kr + ks * 32), qf[ks], a, 0, 0, 0);
#pragma unroll
                for (int j = 0; j < 4; ++j) { const int s = st * 16 + fq * 4 + j, t = tt * 16 + fr; const bool ok = dir ? (s >= t) : (s <= t); a[j] = ok ? a[j] : 0.f; }
                at[st] = a;
            }
#pragma unroll
            for (int kk = 0; kk < 2; ++kk) {
                u32x4 pw; pw.x = cvt_pk_bf16(at[2 * kk][0], at[2 * kk][1]); pw.y = cvt_pk_bf16(at[2 * kk][2], at[2 * kk][3]); pw.z = cvt_pk_bf16(at[2 * kk + 1][0], at[2 * kk + 1][1]); pw.w = cvt_pk_bf16(at[2 * kk + 1][2], at[2 * kk + 1][3]);
                const bf16x8 pf = __builtin_bit_cast(bf16x8, pw);
#pragma unroll
                for (int vt = 0; vt < 4; ++vt) {
                    const int vx = ((((vh * 4 + vt) * 16 + fr) >> 3) & 7) << 3, vc = (2 * kk) * 16 + fq * 4; const bf16_t* vrow = Vt + (size_t)((vh * 4 + vt) * 16 + fr) * SP;
                    u32x4 vw; const u32x2 v0 = *(const u32x2*)(vrow + (vc ^ vx)), v1 = *(const u32x2*)(vrow + ((vc + 16) ^ vx)); vw.x = v0.x; vw.y = v0.y; vw.z = v1.x; vw.w = v1.y;
                    acc[vt] = __builtin_amdgcn_mfma_f32_16x16x32_bf16(__builtin_bit_cast(bf16x8, vw), pf, acc[vt], 0, 0, 0);
                }
            }
            if (A_MASK & 2) {
#pragma unroll
            for (int vt = 0; vt < 4; ++vt)
#pragma unroll
                for (int ks = 0; ks < 4; ++ks) acc[vt] = __builtin_amdgcn_mfma_f32_16x16x32_bf16(sf[dir][vt][ks], qf[ks], acc[vt], 0, 0, 0);
            }
        }
        float ss = 0.f;
#pragma unroll
        for (int vt = 0; vt < 4; ++vt) ss += (acc[vt][0] * acc[vt][0] + acc[vt][1] * acc[vt][1]) + (acc[vt][2] * acc[vt][2] + acc[vt][3] * acc[vt][3]);
        ss += __shfl_xor(ss, 16); ss += __shfl_xor(ss, 32);
        if (fq == 0) red[vh * 64 + tt * 16 + fr] = ss;
        LDS_BAR();
        const float rstd = rsqrtf((red[tt * 16 + fr] + red[64 + tt * 16 + fr]) * (1.f / 128.f) + EPS);
#pragma unroll
        for (int vt = 0; vt < 4; ++vt) {
            const int v0 = (vh * 4 + vt) * 16 + fq * 4;
            const u32x2 gw = gwv[vt];
            const f32x4 nw = *(const f32x4*)(a_norm + v0);
            const float g0 = bf_lo(gw.x), g1 = bf_hi(gw.x), g2 = bf_lo(gw.y), g3 = bf_hi(gw.y);
            u32x2 o;
            o.x = cvt_pk_bf16(acc[vt][0] * rstd * nw[0] * g0 * sigmoidf_(g0), acc[vt][1] * rstd * nw[1] * g1 * sigmoidf_(g1));
            o.y = cvt_pk_bf16(acc[vt][2] * rstd * nw[2] * g2 * sigmoidf_(g2), acc[vt][3] * rstd * nw[3] * g3 * sigmoidf_(g3));
            *(u32x2*)(grow + v0 + (ocol - ZG)) = o;
        }
        LDS_BAR();
    }
}

#define XB_TMO      128
#define XB_XCNT(j)  (256  + 64 * (j))
#define XB_XSUB(j)  (1280 + 64 * (j))
#define XB_XGEN(j)  (2304 + 64 * (j))
#define XB_TOP      3328
#define XB_TOPGEN   3392
#define XCD_BAR_WORDS 3456
#define XB_SPIN_CAP (1u << 20)
constexpr size_t WS_BAR = 896 * 1024;
constexpr int LDS_MISC_OFF = LDS_BYTES - 64;
__device__ __forceinline__ unsigned xb_ld(unsigned* p)              { return __hip_atomic_load(p, __ATOMIC_RELAXED, __HIP_MEMORY_SCOPE_AGENT); }
__device__ __forceinline__ unsigned xb_add(unsigned* p, unsigned v) { return __hip_atomic_fetch_add(p, v, __ATOMIC_RELAXED, __HIP_MEMORY_SCOPE_AGENT); }
__device__ __forceinline__ unsigned xb_xcc_id() { return (unsigned)__builtin_amdgcn_s_getreg((3 << 11) | 20) & 0xFu; }
#define XB_SPIN(cond, bar) do { unsigned _sp = 0; while (cond) { __builtin_amdgcn_s_sleep(1); \
    if ((++_sp & 255u) == 0u) { if (xb_ld(&(bar)[XB_TMO])) break; if (_sp > XB_SPIN_CAP) { atomicAdd(&(bar)[XB_TMO], 1u); break; } } } } while (0)
struct XcdBarrier { unsigned* bar; unsigned x; volatile LAS unsigned* st; };
__device__ __forceinline__ XcdBarrier xcd_barrier_post(unsigned* bar, volatile LAS unsigned* st) {
    XcdBarrier b; b.bar = bar; b.x = xb_xcc_id(); b.st = st;
    if (threadIdx.x == 0) (void)xb_add(&bar[XB_XCNT(b.x)], 1u);
    return b;
}
__device__ __forceinline__ void xcd_barrier_complete(unsigned* bar, unsigned x, unsigned& nloc, unsigned& nx) {
    const unsigned G = gridDim.x * gridDim.y * gridDim.z;
    unsigned sum, cnt, mine, sp = 0u;
    for (;;) {
        sum = 0u; cnt = 0u; mine = 0u;
#pragma unroll
        for (unsigned j = 0; j < 16; ++j) { const unsigned c = xb_ld(&bar[XB_XCNT(j)]); sum += c; cnt += (c > 0u) ? 1u : 0u; mine = (j == x) ? c : mine; }
        if (sum == G) break;
        __builtin_amdgcn_s_sleep(1);
        if ((++sp & 255u) == 0u) { if (xb_ld(&bar[XB_TMO])) break; if (sp > XB_SPIN_CAP) { atomicAdd(&bar[XB_TMO], 1u); break; } }
    }
    nloc = mine > 0u ? mine : 1u; nx = cnt > 0u ? cnt : 1u;
}
__device__ __forceinline__ void xcd_barrier(const XcdBarrier& b) {
    asm volatile("s_waitcnt vmcnt(0)" ::: "memory");
    __syncthreads();
    if (threadIdx.x == 0) {
        unsigned* bar = b.bar;
        __builtin_amdgcn_s_waitcnt(0);
        unsigned nloc = b.st[0], nx = b.st[1];
        if (nloc == 0u) { xcd_barrier_complete(bar, b.x, nloc, nx); b.st[0] = nloc; b.st[1] = nx; }
        const unsigned old = xb_add(&bar[XB_XSUB(b.x)], 1u);
        const unsigned gen = old / nloc;
        if (old + 1u == (gen + 1u) * nloc) {
            __builtin_amdgcn_fence(__ATOMIC_RELEASE, "agent");
            asm volatile("s_waitcnt vmcnt(0)" ::: "memory");
            const unsigned og = xb_add(&bar[XB_TOP], 1u);
            const unsigned tg = og / nx;
            if (og + 1u == (tg + 1u) * nx) xb_add(&bar[XB_TOPGEN], 1u);
            else XB_SPIN(xb_ld(&bar[XB_TOPGEN]) == tg, bar);
            __builtin_amdgcn_fence(__ATOMIC_ACQUIRE, "agent");
            xb_add(&bar[XB_XGEN(b.x)], 1u);
            asm volatile("s_waitcnt vmcnt(0)" ::: "memory");
        } else {
            XB_SPIN(xb_ld(&bar[XB_XGEN(b.x)]) == gen, bar);
            __builtin_amdgcn_fence(__ATOMIC_ACQUIRE, "agent");
            asm volatile("s_waitcnt vmcnt(0)" ::: "memory");
        }
    }
    __syncthreads();
}

struct Args { const float* in[14]; float* out; unsigned char* ws; int ph_lo, ph_hi; };
typedef __attribute__((address_space(4))) const unsigned long long* kargp_t;
__device__ __forceinline__ kargp_t kargs_now() { kargp_t p = (kargp_t)__builtin_amdgcn_kernarg_segment_ptr(); asm volatile("" : "+s"(p)); return p; }
#define GAS1 __attribute__((address_space(1)))
#define KIN(i) ((const float*)(const GAS1 float*)ka[i])
#define KOUT ((float*)(GAS1 float*)ka[14])
#define KWS ((unsigned char*)(GAS1 unsigned char*)ka[15])

__global__ void __launch_bounds__(512, 2) fwd_megakernel(Args a) {
    extern __shared__ __attribute__((aligned(16))) unsigned char lds_raw[];
    LAS unsigned char* ldsl = (LAS unsigned char*)lds_raw;
    const int ph_lo = a.ph_lo, ph_hi = a.ph_hi;
    XcdBarrier xbar; xbar.bar = (unsigned*)(a.ws + WS_BAR); xbar.x = 0; xbar.st = (volatile LAS unsigned*)(ldsl + LDS_MISC_OFF);
    if (USE_XB) {
        if (threadIdx.x < 16) ((LAS unsigned*)(ldsl + LDS_MISC_OFF))[threadIdx.x] = 0u;
        if (blockIdx.x == 0) for (int i = threadIdx.x; i < 4096; i += 512) ((unsigned*)(a.ws + WS_BAR))[i] = 0u;
        __syncthreads();
    }
    for (int ph = ph_lo; ph < ph_hi; ++ph) {
        if (ph > ph_lo) { if (USE_XB && ph > ph_lo + 1) { xcd_barrier(xbar); } else { cg::this_grid().sync(); if (USE_XB) xbar = xcd_barrier_post((unsigned*)(a.ws + WS_BAR), (volatile LAS unsigned*)(ldsl + LDS_MISC_OFF)); } }
        const Ctx c = make_ctx(lds_raw);
        const kargp_t ka = kargs_now();
        unsigned char* ws = KWS;
        bf16_t* Z = (bf16_t*)(ws + WS_Z);
        bf16_t* Wb = (bf16_t*)(ws + WS_W);
        bf16_t* Lg = (bf16_t*)(ws + WS_L);
        float* DEC = (float*)(ws + WS_DEC);
        if (ph == NPH - 1) { if (PHON(10)) rms_rows_f32_inplace(c, KOUT, KIN(13)); continue; }
        const int nrep = DUP_THIN ? 2 : 1;
        const int l = ph / 9, k9 = ph % 9; const int k = k9 < 7 ? k9 : k9 + 1;
        if (k == 0 && PHON(0)) {
            for (int rep = 0; rep < nrep; ++rep) phase_pre(c, l, KIN(1), KIN(2), KIN(3), KIN(5), KIN(8), KIN(9), KIN(10), KIN(11), KIN(12), l == 0 ? KIN(0) : KOUT, ws);
            __syncthreads();
        } else if (k == 1 && PHON(1)) {
            pg8::Gemm g{Z + ZXN, (const bf16_t*)((const char*)Wb + W_IN), T, NZ, D, LDZ}; pg8::StaticOrder S; S.init(T, NZ, c.G, c.bid);
            pg8::EpiZ E{Z, LDZ, (const float*)(ws + WS_LOW), (const f32x2*)(ws + WS_ROPE)};
            if (DUP_GEMM) pg8::gemm_phase<pg8::EpiZ>(ldsl, g, S, E, c.tid);
            pg8::gemm_phase<pg8::EpiZ>(ldsl, g, S, E, c.tid);
        } else if (k == 2 && PHON(2)) {
            const float* lbl = KIN(3);
            for (int u = c.bid; u < 512 + 256 + 2048; u += c.G) {
                const Ctx c = make_ctx(lds_raw);
                if (u < 512) { if (BR_MASK & 1) branch_c_unit(c, Z, KIN(7) + l * 8, u); }
                else if (u < 768) { if (BR_MASK & 2) branch_b_unit(c, Z, (const bf16_t*)(ws + WS_WSB), KIN(6) + (size_t)l * 512, u - 512); }
                else if (BR_MASK & 4) { if (DUP_P1) hgrn_pass1_unit(c, Z, Lg, DEC, (float*)(ws + WS_ENR), u - 768); hgrn_pass1_unit(c, Z, Lg, DEC, (float*)(ws + WS_ENR), u - 768); }
            }
        } else if (k == 3 && PHON(3)) {
            hgrn_scan(c, Lg, DEC, (const float*)(ws + WS_ENR));
        } else if (k == 4 && PHON(4)) {
            hgrn_pass3_phase(lds_raw, Z, KIN(4) + (size_t)l * 128, Lg, c.bid, c.G, ZG);
        } else if (k == 5 && PHON(5)) {
            bf16_t* Mg = (bf16_t*)(ws + WS_MERGED); bf16_t* Sg = (bf16_t*)(ws + WS_SST);
            pg8::StaticOrder S; S.init(T, D, c.G, c.bid);
#pragma unroll 1
            for (int rep = 0; rep < 1 + DUP_GEMM; ++rep)
#pragma unroll 1
            for (int b = 0; b < 3; ++b) {
                pg8::Gemm gg{Z + ZXN, (const bf16_t*)((const char*)Wb + W_IN) + (size_t)(NZ + b * D) * D, T, D, D, LDZ};
                pg8::EpiAct<0> Eg{b == 0 ? Mg : Sg, D, nullptr};
                { const Ctx c2 = make_ctx(lds_raw); pg8::gemm_phase<pg8::EpiAct<0>>(ldsl, gg, S, Eg, c2.tid); }
                const int ycol = b == 0 ? ZG : (b == 1 ? ZU : ZCQ);
                pg8::Gemm gp{Z + ycol, (const bf16_t*)((const char*)Wb + W_BR) + (size_t)b * D * 512, T, D, 512, LDZ};
                const Ctx c3 = make_ctx(lds_raw);
                if (b == 0) { pg8::EpiMul<0> Em{Mg, Sg, D}; pg8::gemm_phase<pg8::EpiMul<0>>(ldsl, gp, S, Em, c3.tid); }
                else { pg8::EpiMul<1> Em{Mg, Sg, D}; pg8::gemm_phase<pg8::EpiMul<1>>(ldsl, gp, S, Em, c3.tid); }
            }
        } else if (k == 6 && PHON(6)) {
            pg8::Gemm g{(const bf16_t*)(ws + WS_MERGED), (const bf16_t*)((const char*)Wb + W_OUT), T, D, D, D}; pg8::StaticOrder S; S.init(T, D, c.G, c.bid);
            pg8::EpiRes<true> E{KIN(0), KOUT, D, (bf16_t*)(ws + WS_SST), (float*)(ws + WS_SUMSQ), l == 0 ? nullptr : (bf16_t*)KOUT};
            pg8::gemm_phase<pg8::EpiRes<true>>(ldsl, g, S, E, c.tid);
        } else if (k == 7 && PHON(7)) {
            for (int rep = 0; rep < nrep; ++rep) rms_rows_bf16(c, KOUT, KIN(10) + (size_t)l * D, (bf16_t*)(ws + WS_HN), D);
        } else if (k == 8 && PHON(8)) {
            pg8::Gemm g{(const bf16_t*)(ws + WS_SST), (const bf16_t*)((const char*)Wb + W_UP), T, DFF, D, D}; pg8::StaticOrder S; S.init(T, DFF, c.G, c.bid);
            pg8::EpiAct<1> E{Z, DFF, (const float*)(ws + WS_SUMSQ)};
            pg8::gemm_phase<pg8::EpiAct<1>>(ldsl, g, S, E, c.tid);
        } else if (k == 9 && PHON(9)) {
            pg8::Gemm g{Z, (const bf16_t*)((const char*)Wb + W_DN), T, D, DFF, DFF}; pg8::StaticOrder S; S.init(T, D, c.G, c.bid);
            pg8::EpiRes<false> E{nullptr, KOUT, D, (bf16_t*)(ws + WS_SST), nullptr, l + 1 < DEPTH ? (bf16_t*)KOUT : nullptr};
            pg8::gemm_phase<pg8::EpiRes<false>>(ldsl, g, S, E, c.tid);
        }
    }
}

extern "C" void kernel_launch(void* const* d_in, const int* in_sizes, int n_in, void* d_out, int out_size, void* d_ws, size_t ws_size, hipStream_t stream) {
    static int grid = 0;
    if (grid == 0) {
        if (n_in != 14 || out_size != T * D || ws_size < WS_END) { fprintf(stderr, "kernel_launch: unexpected shapes (n_in %d out %d ws %zu)\n", n_in, out_size, ws_size); grid = -1; return; }
        int dev = 0, cus = 0, per_cu = 0;
        hipGetDevice(&dev); hipDeviceGetAttribute(&cus, hipDeviceAttributeMultiprocessorCount, dev);
        if (hipFuncSetAttribute((const void*)fwd_megakernel, hipFuncAttributeMaxDynamicSharedMemorySize, LDS_BYTES) != hipSuccess) { fprintf(stderr, "kernel_launch: hipFuncSetAttribute failed\n"); grid = -1; return; }
        if (hipOccupancyMaxActiveBlocksPerMultiprocessor(&per_cu, (const void*)fwd_megakernel, 512, LDS_BYTES) != hipSuccess || per_cu < 1) { fprintf(stderr, "kernel_launch: occupancy query says %d\n", per_cu); per_cu = 1; }
        (void)hipGetLastError();
        grid = cus * 1;
    }
    if (grid < 0) return;
    Args a{};
    for (int i = 0; i < 14; ++i) a.in[i] = (const float*)d_in[i];
    a.out = (float*)d_out; a.ws = (unsigned char*)d_ws;
#if MK_ONE_LAUNCH
    a.ph_lo = 0; a.ph_hi = NPH;
    void* args[] = {&a};
    hipError_t e = hipLaunchCooperativeKernel((const void*)fwd_megakernel, dim3(grid), dim3(512), args, LDS_BYTES, stream);
    if (e != hipSuccess) fprintf(stderr, "cooperative launch failed: %s (grid %d)\n", hipGetErrorString(e), grid);
#else
    for (int ph = 0; ph < NPH; ++ph) {
        a.ph_lo = ph; a.ph_hi = ph + 1;
        hipLaunchKernelGGL(fwd_megakernel, dim3(grid), dim3(512), LDS_BYTES, stream, a);
    }
#endif
}
```

```cpp
#include <hip/hip_runtime.h>
#include <hip/hip_cooperative_groups.h>
#include <cstdio>
#include <cstdint>
namespace cg = cooperative_groups;

#ifndef PH_MASK
#define PH_MASK 0x7ff
#endif
#ifndef BR_MASK
#define BR_MASK 7
#endif
#ifndef A_MASK
#define A_MASK 3
#endif
#ifndef TPROBE_A
#define TPROBE_A -1
#endif
#ifndef TPROBE_B
#define TPROBE_B -1
#endif
#ifndef DUP_GEMM
#define DUP_GEMM 0
#endif
#ifndef DUP_SYNC
#define DUP_SYNC 0
#endif
#ifndef DUP_THIN
#define DUP_THIN 0
#endif
#ifndef USE_XB
#define USE_XB 1
#endif
#ifndef DUP_P1
#define DUP_P1 0
#endif
#ifndef DUP_P3
#define DUP_P3 0
#endif
#ifndef DUP_C
#define DUP_C 0
#endif
#define PHON(n) ((PH_MASK >> (n)) & 1)
#ifndef MK_ONE_LAUNCH
#define MK_ONE_LAUNCH 1
#endif

#define LAS __attribute__((address_space(3)))
typedef unsigned short bf16_t;
typedef short bf16x8 __attribute__((ext_vector_type(8)));
typedef float f32x4 __attribute__((ext_vector_type(4)));
typedef float f32x2 __attribute__((ext_vector_type(2)));
typedef unsigned u32x4 __attribute__((ext_vector_type(4)));
typedef unsigned u32x2 __attribute__((ext_vector_type(2)));

constexpr int T = 32768, SEQ = 8192, D = 1024, DFF = 4096, DIN = 7424, NZ = 4352, LDZ = 5376, DEPTH = 2;
constexpr int ZQ = 0, ZI = 512, ZFF = 1024, ZFB = 1536, ZG = 2048, ZU = 2560, ZV = 3072, ZCQ = 3584, ZCK = 4096, ZCV = 4224, ZXN = 4352;
constexpr float EPS = 1e-6f;
constexpr size_t MiB = 1u << 20;
constexpr size_t WS_ROPE = 0;
constexpr size_t WS_WSB = 1 * MiB;
constexpr size_t WS_LOW = 640 * 1024;
constexpr size_t WS_ETN = 1 * MiB + 256 * 1024;
constexpr size_t WS_SUMSQ = 1 * MiB + 512 * 1024;
constexpr size_t WS_DEC = 2 * MiB;
constexpr size_t WS_W = 4 * MiB;
constexpr size_t W_IN = 0, W_BR = (size_t)DIN * D * 2, W_OUT = W_BR + (size_t)3 * D * 512 * 2, W_UP = W_OUT + (size_t)D * D * 2, W_DN = W_UP + (size_t)DFF * D * 2;
constexpr size_t WS_Z = 40 * MiB;
constexpr size_t WS_L = 376 * MiB;
constexpr size_t WS_MERGED = WS_L, WS_SST = WS_L + 64 * MiB, WS_HN = WS_L;
constexpr size_t WS_ENR = 504 * MiB;
constexpr size_t WS_END = 506 * MiB;
constexpr int LDS_BYTES = 147456;
constexpr int NPH = 9 * DEPTH + 1;

typedef __bf16 bf16v2_t __attribute__((ext_vector_type(2)));
__device__ __forceinline__ unsigned cvt_pk_bf16(float lo, float hi) { const f32x2 v = {lo, hi}; const bf16v2_t b = __builtin_convertvector(v, bf16v2_t); return __builtin_bit_cast(unsigned, b); }
__device__ __forceinline__ float bf_lo(unsigned w) { return __uint_as_float(w << 16); }
__device__ __forceinline__ float bf_hi(unsigned w) { return __uint_as_float(w & 0xffff0000u); }
__device__ __forceinline__ float bf2f(bf16_t b) { return __uint_as_float(((unsigned)b) << 16); }
__device__ __forceinline__ bf16_t f2bf(float f) { return (bf16_t)(cvt_pk_bf16(f, 0.f) & 0xffffu); }
__device__ __forceinline__ float wave_sum(float v) {
#pragma unroll
    for (int o = 1; o < 64; o <<= 1) v += __shfl_xor(v, o);
    return v;
}
__device__ __forceinline__ float gelu_tanh(float x) { const float u = 1.5957691216f * (x + 0.044715f * x * x * x); return x * __builtin_amdgcn_rcpf(1.0f + __expf(-u)); }
__device__ __forceinline__ float sigmoidf_(float x) { return __builtin_amdgcn_rcpf(1.0f + __expf(-x)); }

namespace pg8 {
constexpr int BM = 256, BK = 64, HALF = 128, HTB = HALF * BK * 2, STAGE_BYTES = 8 * HTB, NXCD = 8, WGM = 8;
__host__ __device__ __forceinline__ int lds_byte(int r, int c) { const int st = (r >> 4) * 2 + (c >> 5), rr = r & 15, cc = c & 31, ob = rr * 64 + cc * 2; return st * 1024 + (ob ^ (((ob >> 9) & 1) << 5)); }
__host__ __device__ __forceinline__ void stage_rc(int b, int& R, int& C) { const int st = b / 1024, sb = b % 1024, swz = sb ^ (((sb >> 9) & 1) << 5); R = (st >> 1) * 16 + swz / 64; C = (st & 1) * 32 + (swz % 64) / 2; }
__host__ __device__ __forceinline__ int perm32(int rho) { const int n = rho >> 4, i = rho & 15; return 8 * (i >> 2) + 4 * n + (i & 3); }

struct Unit { int pm, pn; };
struct Gemm { const bf16_t* A; const bf16_t* Bt; int M, N, K, lda; };

struct StaticOrder {
    int nM, nN, nwg, G, c;
    __device__ void init(int M, int N, int G_, int c_) { nM = M / BM; nN = N / BM; nwg = nM * nN; G = G_; c = c_; }
    __device__ bool next(int i, Unit& u) const {
        const long L = (long)i * G + c; if (L >= nwg) return false;
        int wgid = (int)L; { const int q = nwg / NXCD, r = nwg % NXCD, xcd = wgid % NXCD, off = wgid / NXCD; wgid = (xcd < r ? xcd * (q + 1) : r * (q + 1) + (xcd - r) * q) + off; }
        const int nig = WGM * nN, gid = wgid / nig, fm = gid * WGM, gsz = (nM - fm) < WGM ? (nM - fm) : WGM;
        u.pm = fm + ((wgid % nig) % gsz); u.pn = (wgid % nig) / gsz; return true;
    }
};

typedef const f32x4 (&AccRef)[2][2][4][2];

struct EpiZ {
    static constexpr bool PERM = true;
    bf16_t* O; int ldc; const float* low; const f32x2* rope;
    __device__ __forceinline__ void operator()(AccRef acc, const Unit& u, int wr, int wc, int fr, int fq) const {
        const int row0 = u.pm * BM + wr * 64 + fr, col0 = u.pn * BM + wc * 32 + 8 * fq;
        const int mode = (u.pn >= 10 && u.pn < 14) ? 1 : ((u.pn >= 4 && u.pn < 8) ? 2 : (u.pn >= 14 ? 3 : 0));
        const bool rlane = ((wc & 1) == 0) && (fq < 2);
#pragma unroll
        for (int bj = 0; bj < 2; ++bj) {
            f32x4 l0 = (f32x4){0.f, 0.f, 0.f, 0.f}, l1 = l0;
            if (mode == 2) { const float* lp = low + (col0 + bj * HALF - 1024); l0 = *(const f32x4*)lp; l1 = *(const f32x4*)(lp + 4); }
#pragma unroll
            for (int ai = 0; ai < 2; ++ai)
#pragma unroll
                for (int m = 0; m < 4; ++m) { bf16_t* rowp = O + (size_t)(row0 + ai * HALF + m * 16) * ldc + col0;
                    f32x4 v0 = acc[ai][bj][m][0], v1 = acc[ai][bj][m][1];
                    if (mode == 1) {
#pragma unroll
                        for (int j = 0; j < 4; ++j) { v0[j] = gelu_tanh(v0[j]); v1[j] = gelu_tanh(v1[j]); }
                    } else if (mode == 2) {
#pragma unroll
                        for (int j = 0; j < 4; ++j) { v0[j] = __logf(l0[j] + (1.0f - l0[j]) * sigmoidf_(v0[j])); v1[j] = __logf(l1[j] + (1.0f - l1[j]) * sigmoidf_(v1[j])); }
                    } else if (mode == 3 && (u.pn < 16 || bj == 0)) {
                        f32x4 p0, p1;
#pragma unroll
                        for (int j = 0; j < 4; ++j) { p0[j] = __shfl_xor(v0[j], 16); p1[j] = __shfl_xor(v1[j], 16); }
                        if (rlane) {
                            const int pos = (row0 + ai * HALF + m * 16) & (SEQ - 1);
                            const f32x4* rp = (const f32x4*)(rope + (size_t)pos * 8);
                            const f32x4 r0 = rp[0], r1 = rp[1], r2 = rp[2], r3 = rp[3];
                            const float sg = fq == 0 ? -1.f : 1.f;
                            v0[0] = v0[0] * r0.x + sg * p0[0] * r0.y; v0[1] = v0[1] * r0.z + sg * p0[1] * r0.w; v0[2] = v0[2] * r1.x + sg * p0[2] * r1.y; v0[3] = v0[3] * r1.z + sg * p0[3] * r1.w;
                            v1[0] = v1[0] * r2.x + sg * p1[0] * r2.y; v1[1] = v1[1] * r2.z + sg * p1[1] * r2.w; v1[2] = v1[2] * r3.x + sg * p1[2] * r3.y; v1[3] = v1[3] * r3.z + sg * p1[3] * r3.w;
                        }
                    }
                    u32x4 w; w.x = cvt_pk_bf16(v0[0], v0[1]); w.y = cvt_pk_bf16(v0[2], v0[3]); w.z = cvt_pk_bf16(v1[0], v1[1]); w.w = cvt_pk_bf16(v1[2], v1[3]);
                    *(u32x4*)(rowp + bj * HALF) = w; }
        }
    }
};
template <int ACT  > struct EpiAct {
    static constexpr bool PERM = true;
    bf16_t* O; int ldc; const float* sumsq;
    __device__ __forceinline__ void operator()(AccRef acc, const Unit& u, int wr, int wc, int fr, int fq) const {
        const int row0 = u.pm * BM + wr * 64 + fr, col0 = u.pn * BM + wc * 32 + 8 * fq;
#pragma unroll
        for (int ai = 0; ai < 2; ++ai)
#pragma unroll
            for (int m = 0; m < 4; ++m) { bf16_t* rowp = O + (size_t)(row0 + ai * HALF + m * 16) * ldc + col0;
                float r2 = 1.f; if (ACT == 1) r2 = __builtin_amdgcn_rcpf(sumsq[row0 + ai * HALF + m * 16] * (1.f / D) + EPS);
#pragma unroll
                for (int bj = 0; bj < 2; ++bj) { f32x4 v0 = acc[ai][bj][m][0], v1 = acc[ai][bj][m][1];
#pragma unroll
                    for (int j = 0; j < 4; ++j) {
                        if (ACT == 0) { v0[j] = sigmoidf_(v0[j]); v1[j] = sigmoidf_(v1[j]); }
                        else { const float a = fmaxf(v0[j], 0.f), b = fmaxf(v1[j], 0.f); v0[j] = a * a * r2; v1[j] = b * b * r2; } }
                    u32x4 w; w.x = cvt_pk_bf16(v0[0], v0[1]); w.y = cvt_pk_bf16(v0[2], v0[3]); w.z = cvt_pk_bf16(v1[0], v1[1]); w.w = cvt_pk_bf16(v1[2], v1[3]);
                    *(u32x4*)(rowp + bj * HALF) = w; } }
    }
};
struct EpiSig8 {
    static constexpr bool PERM = true;
    unsigned char* O; int ldc;
    __device__ __forceinline__ void operator()(AccRef acc, const Unit& u, int wr, int wc, int fr, int fq) const {
        const int row0 = u.pm * BM + wr * 64 + fr, col0 = u.pn * BM + wc * 32 + 8 * fq;
#pragma unroll
        for (int ai = 0; ai < 2; ++ai)
#pragma unroll
            for (int m = 0; m < 4; ++m) { unsigned char* rowp = O + (size_t)(row0 + ai * HALF + m * 16) * ldc + col0;
#pragma unroll
                for (int bj = 0; bj < 2; ++bj) { const f32x4 v0 = acc[ai][bj][m][0], v1 = acc[ai][bj][m][1];
                    unsigned q[8];
#pragma unroll
                    for (int j = 0; j < 4; ++j) { q[j] = (unsigned)(sigmoidf_(v0[j]) * 255.0f + 0.5f); q[4 + j] = (unsigned)(sigmoidf_(v1[j]) * 255.0f + 0.5f); }
                    u32x2 w; w.x = q[0] | (q[1] << 8) | (q[2] << 16) | (q[3] << 24); w.y = q[4] | (q[5] << 8) | (q[6] << 16) | (q[7] << 24);
                    *(u32x2*)(rowp + bj * HALF) = w; } }
    }
};
template <int MODE  > struct EpiMul {
    static constexpr bool PERM = true;
    bf16_t* Mg; const unsigned char* Sg; int ldc;
    __device__ __forceinline__ void operator()(AccRef acc, const Unit& u, int wr, int wc, int fr, int fq) const {
        const int row0 = u.pm * BM + wr * 64 + fr, col0 = u.pn * BM + wc * 32 + 8 * fq;
#pragma unroll
        for (int ai = 0; ai < 2; ++ai)
#pragma unroll
            for (int m = 0; m < 4; ++m) { const size_t off = (size_t)(row0 + ai * HALF + m * 16) * ldc + col0;
#pragma unroll
                for (int bj = 0; bj < 2; ++bj) { const f32x4 v0 = acc[ai][bj][m][0], v1 = acc[ai][bj][m][1];
                    const u32x2 sw = *(const u32x2*)(Sg + off + bj * HALF);
                    constexpr float K8 = 1.0f / 255.0f;
                    const float s0 = (float)(sw.x & 0xffu) * K8, s1 = (float)((sw.x >> 8) & 0xffu) * K8, s2 = (float)((sw.x >> 16) & 0xffu) * K8, s3 = (float)(sw.x >> 24) * K8;
                    const float s4 = (float)(sw.y & 0xffu) * K8, s5 = (float)((sw.y >> 8) & 0xffu) * K8, s6 = (float)((sw.y >> 16) & 0xffu) * K8, s7 = (float)(sw.y >> 24) * K8;
                    u32x4 w;
                    if (MODE == 0) {
                        w.x = cvt_pk_bf16(s0 * v0[0], s1 * v0[1]); w.y = cvt_pk_bf16(s2 * v0[2], s3 * v0[3]);
                        w.z = cvt_pk_bf16(s4 * v1[0], s5 * v1[1]); w.w = cvt_pk_bf16(s6 * v1[2], s7 * v1[3]);
                    } else {
                        const u32x4 mw = *(const u32x4*)(Mg + off + bj * HALF);
                        w.x = cvt_pk_bf16(bf_lo(mw.x) + s0 * v0[0], bf_hi(mw.x) + s1 * v0[1]); w.y = cvt_pk_bf16(bf_lo(mw.y) + s2 * v0[2], bf_hi(mw.y) + s3 * v0[3]);
                        w.z = cvt_pk_bf16(bf_lo(mw.z) + s4 * v1[0], bf_hi(mw.z) + s5 * v1[1]); w.w = cvt_pk_bf16(bf_lo(mw.w) + s6 * v1[2], bf_hi(mw.w) + s7 * v1[3]);
                    }
                    *(u32x4*)(Mg + off + bj * HALF) = w; }
                if (m & 1) asm volatile("" ::: "memory"); }
    }
};
template <bool SQ> struct EpiRes {
    static constexpr bool PERM = false;
    const float* base; float* out; int ldc; bf16_t* xb; float* sumsq; bf16_t* rb;
    __device__ __forceinline__ void operator()(AccRef acc, const Unit& u, int wr, int wc, int fr, int fq) const {
        const int row0 = u.pm * BM + wr * 64 + fr, col0 = u.pn * BM + wc * 32 + 4 * fq;
#pragma unroll
        for (int ai = 0; ai < 2; ++ai)
#pragma unroll
            for (int m = 0; m < 4; ++m) { const int row = row0 + ai * HALF + m * 16; const size_t off = (size_t)row * ldc + col0; float ss = 0.f;
#pragma unroll
                for (int bj = 0; bj < 2; ++bj)
#pragma unroll
                    for (int n = 0; n < 2; ++n) {
                        if (SQ) { f32x4 b; if (rb) { const u32x2 rw = *(const u32x2*)(rb + off + bj * HALF + n * 16); b[0] = bf_lo(rw.x); b[1] = bf_hi(rw.x); b[2] = bf_lo(rw.y); b[3] = bf_hi(rw.y); } else b = *(const f32x4*)(base + off + bj * HALF + n * 16);
                            const f32x4 v = b + acc[ai][bj][m][n];
                            ss += (v[0] * v[0] + v[1] * v[1]) + (v[2] * v[2] + v[3] * v[3]); u32x2 w; w.x = cvt_pk_bf16(v[0], v[1]); w.y = cvt_pk_bf16(v[2], v[3]); *(u32x2*)(xb + off + bj * HALF + n * 16) = w; }
                        else { const u32x2 bw = *(const u32x2*)(xb + off + bj * HALF + n * 16); const f32x4 a4 = acc[ai][bj][m][n];
                            f32x4 v; v[0] = bf_lo(bw.x) + a4[0]; v[1] = bf_hi(bw.x) + a4[1]; v[2] = bf_lo(bw.y) + a4[2]; v[3] = bf_hi(bw.y) + a4[3];
                            if (rb) { u32x2 w; w.x = cvt_pk_bf16(v[0], v[1]); w.y = cvt_pk_bf16(v[2], v[3]); *(u32x2*)(rb + off + bj * HALF + n * 16) = w; } else *(f32x4*)(out + off + bj * HALF + n * 16) = v; } }
                if (SQ) { ss += __shfl_xor(ss, 16); ss += __shfl_xor(ss, 32); if (fq == 0) __hip_atomic_fetch_add(sumsq + row, ss, __ATOMIC_RELAXED, __HIP_MEMORY_SCOPE_AGENT); }
                if (m & 1) asm volatile("" ::: "memory"); }
    }
};

template <class Epi>
__device__ __forceinline__ void gemm_phase(LAS unsigned char* lds, const Gemm g, const StaticOrder& S, const Epi& E, const int tid) {
    const int wid = __builtin_amdgcn_readfirstlane(tid >> 6), lane = tid & 63, wr = wid >> 2, wc = wid & 3, fr = lane & 15, fq = lane >> 4;
    const int K = g.K, nt = K / BK;
    unsigned voffA[2], voffB[2];
#pragma unroll
    for (int i = 0; i < 2; ++i) { int R, C; stage_rc(tid * 16 + i * 8192, R, C); const int Rb = Epi::PERM ? ((R & ~31) + perm32(R & 31)) : R;
        voffA[i] = (unsigned)(R * g.lda + C) * 2u; voffB[i] = (unsigned)(Rb * K + C) * 2u; }
    const size_t kstep = (size_t)(BK * 2);
    const size_t hstepA = (size_t)HALF * g.lda * 2, hstepB = (size_t)HALF * K * 2;
    const size_t tstepA = 2 * hstepA, tstepB = 2 * hstepB;
    const unsigned ldsw = (unsigned)wid * 1024u;
    const int aoff = lds_byte(wr * 64 + fr, fq * 8), boff = lds_byte(wc * 32 + fr, fq * 8);
#define PG8_SA(b, h) (((b) * 2 + (h)) * HTB)
#define PG8_SB(b, h) ((4 + (b) * 2 + (h)) * HTB)
#define PG8_STAGE(bufoff, gbase, voff) do { _Pragma("unroll") for (int _i = 0; _i < 2; ++_i) \
        __builtin_amdgcn_global_load_lds((const unsigned*)((const char*)(gbase) + (voff)[_i]), (LAS unsigned*)(lds + (bufoff) + ldsw + _i * 8192), 16, 0, 0); } while (0)
#define PG8_LDA(dst, b, h) do { _Pragma("unroll") for (int m = 0; m < 4; ++m) _Pragma("unroll") for (int k = 0; k < 2; ++k) dst[m][k] = *(const LAS bf16x8*)(lds + PG8_SA(b, h) + aoff + m * 2048 + k * 1024); } while (0)
#define PG8_LDB(dst, b, h) do { _Pragma("unroll") for (int n = 0; n < 2; ++n) _Pragma("unroll") for (int k = 0; k < 2; ++k) dst[n][k] = *(const LAS bf16x8*)(lds + PG8_SB(b, h) + boff + n * 2048 + k * 1024); } while (0)
#define PG8_MMA(ai, bj, At, Bt) do { __builtin_amdgcn_s_setprio(1); _Pragma("unroll") for (int m = 0; m < 4; ++m) _Pragma("unroll") for (int n = 0; n < 2; ++n) _Pragma("unroll") for (int k = 0; k < 2; ++k) \
        acc[ai][bj][m][n] = __builtin_amdgcn_mfma_f32_16x16x32_bf16(Bt[n][k], At[m][k], acc[ai][bj][m][n], 0, 0, 0); __builtin_amdgcn_s_setprio(0); } while (0)
#define PG8_WAIT_V(n) asm volatile("s_waitcnt vmcnt(" #n ")" ::: "memory")
#define PG8_WAIT_L(n) asm volatile("s_waitcnt lgkmcnt(" #n ")" ::: "memory")
#define PG8_BAR __builtin_amdgcn_s_barrier()
#define PG8_SCHED __builtin_amdgcn_sched_barrier(0)
    Unit cur, nxt; int ui = 0;
    if (!S.next(0, cur)) return;
    f32x4 acc[2][2][4][2];
#pragma unroll
    for (int a = 0; a < 2; ++a)
#pragma unroll
        for (int b = 0; b < 2; ++b)
#pragma unroll
            for (int m = 0; m < 4; ++m)
#pragma unroll
                for (int n = 0; n < 2; ++n) acc[a][b][m][n] = (f32x4){0.f, 0.f, 0.f, 0.f};
    bf16x8 At[4][2], B0[2][2], B1[2][2];
    const char* cA = (const char*)g.A + (size_t)cur.pm * tstepA; const char* cB = (const char*)g.Bt + (size_t)cur.pn * tstepB;
    PG8_STAGE(PG8_SB(0, 0), cB, voffB); PG8_STAGE(PG8_SB(0, 1), cB + hstepB, voffB); PG8_STAGE(PG8_SA(0, 0), cA, voffA); PG8_STAGE(PG8_SA(0, 1), cA + hstepA, voffA);
    if (wr == 1) PG8_BAR;
    PG8_WAIT_V(2); PG8_BAR;
    PG8_STAGE(PG8_SB(1, 0), cB + kstep, voffB); PG8_STAGE(PG8_SA(1, 0), cA + kstep, voffA); PG8_STAGE(PG8_SB(1, 1), cB + hstepB + kstep, voffB);
    PG8_WAIT_V(6); PG8_BAR;
    for (;;) {
        const bool has_next = S.next(ui + 1, nxt);
        const char* nA = has_next ? (const char*)g.A + (size_t)nxt.pm * tstepA : cA; const char* nB = has_next ? (const char*)g.Bt + (size_t)nxt.pn * tstepB : cB;
        for (int t = 0; t < nt; t += 2) {
            const bool last = (t == nt - 2);
            const char* a1 = cA + (size_t)(t + 1) * kstep;
            const char* a2 = last ? nA : cA + (size_t)(t + 2) * kstep; const char* b2 = last ? nB : cB + (size_t)(t + 2) * kstep;
            const char* a3 = a2 + kstep; const char* b3 = b2 + kstep;
            PG8_LDB(B0, 0, 0); PG8_LDB(B1, 0, 1); PG8_SCHED; PG8_LDA(At, 0, 0); PG8_STAGE(PG8_SA(1, 1), a1 + hstepA, voffA);
            PG8_WAIT_V(8); PG8_WAIT_L(0); PG8_BAR; PG8_MMA(0, 0, At, B0); PG8_MMA(0, 1, At, B1); PG8_BAR; PG8_SCHED;
            PG8_LDA(At, 0, 1); PG8_STAGE(PG8_SB(0, 0), b2, voffB); PG8_STAGE(PG8_SB(0, 1), b2 + hstepB, voffB); PG8_STAGE(PG8_SA(0, 0), a2, voffA);
            PG8_WAIT_V(8); PG8_WAIT_L(0); PG8_BAR; PG8_MMA(1, 0, At, B0); PG8_MMA(1, 1, At, B1); PG8_BAR; PG8_SCHED;
            PG8_LDB(B0, 1, 0); PG8_LDB(B1, 1, 1); PG8_SCHED; PG8_LDA(At, 1, 0); PG8_STAGE(PG8_SA(0, 1), a2 + hstepA, voffA);
            PG8_WAIT_V(8); PG8_WAIT_L(0); PG8_BAR; PG8_MMA(0, 0, At, B0); PG8_MMA(0, 1, At, B1); PG8_BAR; PG8_SCHED;
            PG8_LDA(At, 1, 1); PG8_STAGE(PG8_SB(1, 0), b3, voffB); PG8_STAGE(PG8_SB(1, 1), b3 + hstepB, voffB); PG8_STAGE(PG8_SA(1, 0), a3, voffA);
            PG8_WAIT_V(8); PG8_WAIT_L(0); PG8_BAR; PG8_MMA(1, 0, At, B0); PG8_MMA(1, 1, At, B1); PG8_BAR; PG8_SCHED;
        }
        if (wr == 0) PG8_BAR;
        E(acc, cur, wr, wc, fr, fq);
        if (!has_next) break;
#pragma unroll
        for (int a = 0; a < 2; ++a)
#pragma unroll
            for (int b = 0; b < 2; ++b)
#pragma unroll
                for (int m = 0; m < 4; ++m)
#pragma unroll
                    for (int n = 0; n < 2; ++n) acc[a][b][m][n] = (f32x4){0.f, 0.f, 0.f, 0.f};
        cur = nxt; cA = nA; cB = nB; ++ui;
        if (wr == 1) PG8_BAR;
    }
    PG8_WAIT_V(0);
    PG8_BAR;
#undef PG8_SA
#undef PG8_SB
#undef PG8_STAGE
#undef PG8_LDA
#undef PG8_LDB
#undef PG8_MMA
#undef PG8_WAIT_V
#undef PG8_WAIT_L
#undef PG8_BAR
#undef PG8_SCHED
}
}

struct Ctx { unsigned char* lds; int tid, lane, wave, bid, G; };
__device__ __forceinline__ Ctx make_ctx(unsigned char* lds) { int tid = threadIdx.x; asm volatile("" : "+v"(tid)); Ctx c; c.lds = lds; c.tid = tid; c.lane = tid & 63; c.wave = __builtin_amdgcn_readfirstlane(tid >> 6); c.bid = blockIdx.x; c.G = gridDim.x; return c; }

__device__ __forceinline__ void transpose_item(const float* W, int K, int N, bf16_t* WT, float* scr, int item, int lane, const float* kscale = nullptr) {
    const int nblk = N / 32, kb = item / nblk, nb = item % nblk, k0 = 64 * kb, n0 = 32 * nb;
#pragma unroll 8
    for (int i = 0; i < 32; ++i) { const int kk = 2 * i + (lane >> 5); scr[kk * 33 + (lane & 31)] = W[(size_t)(k0 + kk) * N + n0 + (lane & 31)] * (kscale ? kscale[k0 + kk] : 1.f); }
    asm volatile("s_waitcnt lgkmcnt(0)" ::: "memory");
    const int c = lane & 7;
#pragma unroll
    for (int j = 0; j < 4; ++j) { const int n = (lane >> 3) + 8 * j; const float* s = scr + (8 * c) * 33 + n;
        u32x4 o; o.x = cvt_pk_bf16(s[0 * 33], s[1 * 33]); o.y = cvt_pk_bf16(s[2 * 33], s[3 * 33]); o.z = cvt_pk_bf16(s[4 * 33], s[5 * 33]); o.w = cvt_pk_bf16(s[6 * 33], s[7 * 33]);
        *(u32x4*)(WT + (size_t)(n0 + n) * K + k0 + 8 * c) = o; }
    asm volatile("s_waitcnt lgkmcnt(0)" ::: "memory");
}

__device__ __forceinline__ void rms_rows_bf16(const Ctx& c, const float* src, const float* w, bf16_t* dst, int ldo) {
    const int gw = c.bid * 8 + c.wave, NGW = c.G * 8;
    f32x4 wv[4];
#pragma unroll
    for (int j = 0; j < 4; ++j) wv[j] = *((const f32x4*)w + c.lane + 64 * j);
    for (int m = gw; m < T; m += NGW) {
        const f32x4* xr = (const f32x4*)(src + (size_t)m * D) + c.lane;
        f32x4 v[4]; float s = 0.f;
#pragma unroll
        for (int j = 0; j < 4; ++j) { v[j] = xr[64 * j]; s += (v[j].x * v[j].x + v[j].y * v[j].y) + (v[j].z * v[j].z + v[j].w * v[j].w); }
        const float rstd = rsqrtf(wave_sum(s) * (1.f / D) + EPS);
        u32x2* o8 = (u32x2*)(dst + (size_t)m * ldo) + c.lane;
#pragma unroll
        for (int j = 0; j < 4; ++j) { u32x2 o; o.x = cvt_pk_bf16(v[j].x * rstd * wv[j].x, v[j].y * rstd * wv[j].y); o.y = cvt_pk_bf16(v[j].z * rstd * wv[j].z, v[j].w * rstd * wv[j].w); o8[64 * j] = o; }
    }
}
__device__ __forceinline__ void rms_rows_bf16_src(const Ctx& c, const bf16_t* src, const float* w, bf16_t* dst, int ldo) {
    const int gw = c.bid * 8 + c.wave, NGW = c.G * 8;
    f32x4 wv[4];
#pragma unroll
    for (int j = 0; j < 4; ++j) wv[j] = *((const f32x4*)w + c.lane + 64 * j);
    for (int m = gw; m < T; m += NGW) {
        const u32x2* xr = (const u32x2*)(src + (size_t)m * D) + c.lane;
        f32x4 v[4]; float s = 0.f;
#pragma unroll
        for (int j = 0; j < 4; ++j) { const u32x2 r = xr[64 * j]; v[j].x = bf_lo(r.x); v[j].y = bf_hi(r.x); v[j].z = bf_lo(r.y); v[j].w = bf_hi(r.y); s += (v[j].x * v[j].x + v[j].y * v[j].y) + (v[j].z * v[j].z + v[j].w * v[j].w); }
        const float rstd = rsqrtf(wave_sum(s) * (1.f / D) + EPS);
        u32x2* o8 = (u32x2*)(dst + (size_t)m * ldo) + c.lane;
#pragma unroll
        for (int j = 0; j < 4; ++j) { u32x2 o; o.x = cvt_pk_bf16(v[j].x * rstd * wv[j].x, v[j].y * rstd * wv[j].y); o.y = cvt_pk_bf16(v[j].z * rstd * wv[j].z, v[j].w * rstd * wv[j].w); o8[64 * j] = o; }
    }
}
__device__ __forceinline__ void rms_rows_f32_inplace(const Ctx& c, float* x, const float* w) {
    const int gw = c.bid * 8 + c.wave, NGW = c.G * 8;
    f32x4 wv[4];
#pragma unroll
    for (int j = 0; j < 4; ++j) wv[j] = *((const f32x4*)w + c.lane + 64 * j);
    for (int m = gw; m < T; m += NGW) {
        f32x4* xr = (f32x4*)(x + (size_t)m * D) + c.lane;
        f32x4 v[4]; float s = 0.f;
#pragma unroll
        for (int j = 0; j < 4; ++j) { v[j] = xr[64 * j]; s += (v[j].x * v[j].x + v[j].y * v[j].y) + (v[j].z * v[j].z + v[j].w * v[j].w); }
        const float rstd = rsqrtf(wave_sum(s) * (1.f / D) + EPS);
#pragma unroll
        for (int j = 0; j < 4; ++j) xr[64 * j] = v[j] * rstd * wv[j];
    }
}

__device__ __forceinline__ float lower_bound_of(const float* lb_logits, int l, int dir, int col) {
    if (l == 0) return 0.f;
    const float l0 = lb_logits[dir * 512 + col], l1 = lb_logits[1024 + dir * 512 + col];
    return 1.0f / (1.0f + __expf(l0 - l1));
}

__device__ __forceinline__ void phase_pre(const Ctx& c, int l, const float* in1, const float* in2, const float* in3, const float* in5, const float* in8, const float* in9, const float* in10, const float* in11, const float* in12, const float* xsrc, unsigned char* ws) {
    float* scr = (float*)(c.lds + c.wave * 8704);
    const int gw = c.bid * 8 + c.wave, NGW = c.G * 8;
    bf16_t* Wb = (bf16_t*)(ws + WS_W);
    const float* w_in = in1 + (size_t)l * D * DIN; const float* w_br = in8 + (size_t)l * 3 * 512 * D; const float* w_out = in9 + (size_t)l * D * D;
    const float* w_up = in11 + (size_t)l * D * DFF; const float* w_dn = in12 + (size_t)l * DFF * D;
    constexpr int I_IN = (D / 64) * (DIN / 32), I_BR = (512 / 64) * (D / 32), I_OUT = (D / 64) * (D / 32), I_UP = (D / 64) * (DFF / 32), I_DN = (DFF / 64) * (D / 32);
    constexpr int NITEMS = I_IN + 3 * I_BR + I_OUT + I_UP + I_DN;
    for (int it = gw; it < NITEMS; it += NGW) {
        int r = it;
        if (r < I_IN) { transpose_item(w_in, D, DIN, (bf16_t*)((char*)Wb + W_IN), scr, r, c.lane); continue; } r -= I_IN;
        if (r < 3 * I_BR) { const int b = r / I_BR; transpose_item(w_br + (size_t)b * 512 * D, 512, D, (bf16_t*)((char*)Wb + W_BR) + (size_t)b * D * 512, scr, r % I_BR, c.lane); continue; } r -= 3 * I_BR;
        if (r < I_OUT) { transpose_item(w_out, D, D, (bf16_t*)((char*)Wb + W_OUT), scr, r, c.lane); continue; } r -= I_OUT;
        if (r < I_UP) { transpose_item(w_up, D, DFF, (bf16_t*)((char*)Wb + W_UP), scr, r, c.lane, in10 + (size_t)l * D); continue; } r -= I_UP;
        transpose_item(w_dn, DFF, D, (bf16_t*)((char*)Wb + W_DN), scr, r, c.lane);
    }
    const int gt = c.bid * 512 + c.tid, NGT = c.G * 512;
    {
        const float* wsrc = in5 + (size_t)l * 4 * 128 * 128; bf16_t* wd = (bf16_t*)(ws + WS_WSB);
        for (int i = gt; i < 4 * 128 * 128; i += NGT) wd[i] = f2bf(wsrc[i]);
    }
    {   float* sq = (float*)(ws + WS_SUMSQ); for (int i = gt; i < T; i += NGT) sq[i] = 0.f; }
    {
        float* low = (float*)(ws + WS_LOW);
        for (int i = gt; i < 1024; i += NGT) low[i] = lower_bound_of(in3, l, i >> 9, i & 511);
    }
    if (l == 0) {
        f32x2* rt = (f32x2*)(ws + WS_ROPE);
        for (int i = gt; i < SEQ * 8; i += NGT) {
            const int pos = i >> 3, j = i & 7;
            const float inv = j == 0 ? 1.0f : j == 1 ? 0.1939227432012558f : j == 2 ? 0.03760603070259094f : j == 3 ? 0.007292664609849453f : j == 4 ? 0.0014142135623842478f : j == 5 ? 0.00027424818836152554f : j == 6 ? 5.318296098266728e-05f : 1.0313386155758053e-05f;
            const float ang = (float)pos * inv;
            const double rev = (double)ang * 0.15915494309189535; const double fr = rev - __builtin_rint(rev);
            const float f = (float)fr;
            rt[i] = (f32x2){__builtin_amdgcn_cosf(f), __builtin_amdgcn_sinf(f)};
        }
    }
    if (l == 0) rms_rows_bf16(c, xsrc, in2 + (size_t)l * D, (bf16_t*)(ws + WS_Z) + ZXN, LDZ);
    else rms_rows_bf16_src(c, (const bf16_t*)xsrc, in2 + (size_t)l * D, (bf16_t*)(ws + WS_Z) + ZXN, LDZ);
}

__device__ __forceinline__ void branch_b_unit(const Ctx& c, bf16_t* Z, const bf16_t* WSB, const float* bs, int unit) {
    constexpr int VP = 136;
    bf16_t* vnT = (bf16_t*)c.lds;
    bf16_t* zrow0 = Z + (size_t)unit * 128 * LDZ;
    const int fr = c.lane & 15, fq = c.lane >> 4;
    {
        const int p = c.wave * 16 + fr;
        const bf16_t* src = zrow0 + (size_t)p * LDZ + ZV + fq * 128;
        u32x4 raw[16]; float s = 0.f;
#pragma unroll
        for (int i = 0; i < 16; ++i) { raw[i] = *(const u32x4*)(src + i * 8);
            s += (bf_lo(raw[i].x) + bf_hi(raw[i].x)) + (bf_lo(raw[i].y) + bf_hi(raw[i].y)) + (bf_lo(raw[i].z) + bf_hi(raw[i].z)) + (bf_lo(raw[i].w) + bf_hi(raw[i].w)); }
        s += __shfl_xor(s, 16); s += __shfl_xor(s, 32);
        const float mean = s * (1.f / 512.f); float q = 0.f;
#pragma unroll
        for (int i = 0; i < 16; ++i) {
            float d;
            d = bf_lo(raw[i].x) - mean; q += d * d; d = bf_hi(raw[i].x) - mean; q += d * d; d = bf_lo(raw[i].y) - mean; q += d * d; d = bf_hi(raw[i].y) - mean; q += d * d;
            d = bf_lo(raw[i].z) - mean; q += d * d; d = bf_hi(raw[i].z) - mean; q += d * d; d = bf_lo(raw[i].w) - mean; q += d * d; d = bf_hi(raw[i].w) - mean; q += d * d; }
        q += __shfl_xor(q, 16); q += __shfl_xor(q, 32);
        const float rstd = rsqrtf(q * (1.f / 512.f) + EPS);
        bf16_t* dst = vnT + (size_t)(fq * 128) * VP + p;
#pragma unroll
        for (int i = 0; i < 16; ++i) {
            dst[(i * 8 + 0) * VP] = f2bf((bf_lo(raw[i].x) - mean) * rstd); dst[(i * 8 + 1) * VP] = f2bf((bf_hi(raw[i].x) - mean) * rstd);
            dst[(i * 8 + 2) * VP] = f2bf((bf_lo(raw[i].y) - mean) * rstd); dst[(i * 8 + 3) * VP] = f2bf((bf_hi(raw[i].y) - mean) * rstd);
            dst[(i * 8 + 4) * VP] = f2bf((bf_lo(raw[i].z) - mean) * rstd); dst[(i * 8 + 5) * VP] = f2bf((bf_hi(raw[i].z) - mean) * rstd);
            dst[(i * 8 + 6) * VP] = f2bf((bf_lo(raw[i].w) - mean) * rstd); dst[(i * 8 + 7) * VP] = f2bf((bf_hi(raw[i].w) - mean) * rstd); }
    }
    __syncthreads();
    const int q = c.wave * 16 + fr;
#pragma unroll 1
    for (int g = 0; g < 4; ++g) {
        bf16x8 wf[4];
#pragma unroll
        for (int kk = 0; kk < 4; ++kk) wf[kk] = *(const bf16x8*)(WSB + (size_t)(g * 128 + q) * 128 + kk * 32 + fq * 8);
        const float bias = bs[g * 128 + q];
        bf16_t* ub = zrow0 + (size_t)q * LDZ + ZU + g * 128 + fq * 4;
        u32x2 uu[8];
#pragma unroll
        for (int ct = 0; ct < 8; ++ct) uu[ct] = *(const u32x2*)(ub + ct * 16);
#pragma unroll
        for (int ct = 0; ct < 8; ++ct) {
            f32x4 acc = (f32x4){0.f, 0.f, 0.f, 0.f};
#pragma unroll
            for (int kk = 0; kk < 4; ++kk) { const bf16x8 a = *(const bf16x8*)(vnT + (size_t)(g * 128 + ct * 16 + fr) * VP + kk * 32 + fq * 8); acc = __builtin_amdgcn_mfma_f32_16x16x32_bf16(a, wf[kk], acc, 0, 0, 0); }
            u32x2 o; o.x = cvt_pk_bf16(bf_lo(uu[ct].x) * (acc[0] + bias), bf_hi(uu[ct].x) * (acc[1] + bias)); o.y = cvt_pk_bf16(bf_lo(uu[ct].y) * (acc[2] + bias), bf_hi(uu[ct].y) * (acc[3] + bias));
            *(u32x2*)(ub + ct * 16) = o;
        }
    }
    __syncthreads();
}

__device__ __forceinline__ void branch_c_unit(const Ctx& c, bf16_t* Z, const float* sink, int unit) {
    constexpr int KP = 72, VTP = 408;
    bf16_t* Ks = (bf16_t*)c.lds;
    bf16_t* Vt = (bf16_t*)(c.lds + 400 * KP * 2);
    const int hk = unit & 1, n = (unit >> 1) & 63, b = unit >> 7;
    const int fr = c.lane & 15, fq = c.lane >> 4;
    const size_t rowb = (size_t)b * SEQ;
    const int g = c.wave >> 1, half = c.wave & 1, head = hk * 4 + g;
    bf16_t* qrow0 = Z + (rowb + n * 128 + half * 64 + fr) * LDZ + ZCQ + head * 64;
    u32x4 qa[4], qb[4];
#pragma unroll
    for (int qt = 0; qt < 4; ++qt) { qa[qt] = *(const u32x4*)(qrow0 + (size_t)qt * 16 * LDZ + fq * 8); qb[qt] = *(const u32x4*)(qrow0 + (size_t)qt * 16 * LDZ + 32 + fq * 8); }
    {
        u32x4 kv[7], vv[7];
#pragma unroll
        for (int it = 0; it < 7; ++it) {
            const int chunk = c.tid + 512 * it; const int row = chunk >> 3, part = chunk & 7;
            const int tk = (n - 1) * 128 + row;
            const bool valid = row < 384 && tk >= 0 && tk < SEQ;
            kv[it] = (u32x4){0u, 0u, 0u, 0u}; vv[it] = (u32x4){0u, 0u, 0u, 0u};
            if (valid) { const bf16_t* zr = Z + (rowb + tk) * LDZ; kv[it] = *(const u32x4*)(zr + ZCK + hk * 64 + part * 8); vv[it] = *(const u32x4*)(zr + ZCV + hk * 64 + part * 8); }
        }
#pragma unroll
        for (int it = 0; it < 7; ++it) {
            const int chunk = c.tid + 512 * it; const int row = chunk >> 3, part = chunk & 7;
            if (row < 400) {
                *(u32x4*)(Ks + row * KP + part * 8) = kv[it];
                bf16_t* vd = Vt + (part * 8) * VTP + row;
                vd[0 * VTP] = (bf16_t)(vv[it].x & 0xffffu); vd[1 * VTP] = (bf16_t)(vv[it].x >> 16); vd[2 * VTP] = (bf16_t)(vv[it].y & 0xffffu); vd[3 * VTP] = (bf16_t)(vv[it].y >> 16);
                vd[4 * VTP] = (bf16_t)(vv[it].z & 0xffffu); vd[5 * VTP] = (bf16_t)(vv[it].z >> 16); vd[6 * VTP] = (bf16_t)(vv[it].w & 0xffffu); vd[7 * VTP] = (bf16_t)(vv[it].w >> 16);
            }
        }
    }
    __syncthreads();
    const float sk = sink[head];
    const int base = fq * 4 - fr;
#pragma unroll
    for (int qt = 0; qt < 4; ++qt) {
        const int q0 = half * 64 + qt * 16;
        const bf16x8 qf0 = __builtin_bit_cast(bf16x8, qa[qt]), qf1 = __builtin_bit_cast(bf16x8, qb[qt]);
        const int kt0 = q0 >> 4;
        f32x4 s[17]; float mx = sk;
#pragma unroll
        for (int tt = 0; tt < 17; ++tt) {
            const int kt = kt0 + tt;
            const bool tile_ok = !((n == 0 && kt < 8) || (n == 63 && kt >= 16));
            f32x4 a = (f32x4){-1e30f, -1e30f, -1e30f, -1e30f};
            if (tile_ok) {
                const bf16_t* kr = Ks + (kt * 16 + fr) * KP + fq * 8;
                a = (f32x4){0.f, 0.f, 0.f, 0.f};
                a = __builtin_amdgcn_mfma_f32_16x16x32_bf16(*(const bf16x8*)kr, qf0, a, 0, 0, 0);
                a = __builtin_amdgcn_mfma_f32_16x16x32_bf16(*(const bf16x8*)(kr + 32), qf1, a, 0, 0, 0);
#pragma unroll
                for (int j = 0; j < 4; ++j) {
                    float v = a[j] * 0.125f;
                    if (tt == 0) v = (base + j >= 0) ? v : -1e30f;
                    if (tt == 16) v = (base + j <= 0) ? v : -1e30f;
                    a[j] = v; mx = fmaxf(mx, v);
                }
            }
            s[tt] = a;
        }
        mx = fmaxf(mx, __shfl_xor(mx, 16)); mx = fmaxf(mx, __shfl_xor(mx, 32));
        float lsum = 0.f;
#pragma unroll
        for (int tt = 0; tt < 17; ++tt)
#pragma unroll
            for (int j = 0; j < 4; ++j) { const float p = __expf(s[tt][j] - mx); s[tt][j] = p; lsum += p; }
        lsum += __shfl_xor(lsum, 16); lsum += __shfl_xor(lsum, 32);
        lsum += __expf(sk - mx);
        const float rl = __builtin_amdgcn_rcpf(lsum);
        f32x4 o[4];
#pragma unroll
        for (int dt = 0; dt < 4; ++dt) o[dt] = (f32x4){0.f, 0.f, 0.f, 0.f};
#pragma unroll
        for (int kk = 0; kk < 9; ++kk) {
            u32x4 pw; pw.x = cvt_pk_bf16(s[2 * kk][0], s[2 * kk][1]); pw.y = cvt_pk_bf16(s[2 * kk][2], s[2 * kk][3]);
            if (kk < 8) { pw.z = cvt_pk_bf16(s[2 * kk + 1][0], s[2 * kk + 1][1]); pw.w = cvt_pk_bf16(s[2 * kk + 1][2], s[2 * kk + 1][3]); } else { pw.z = 0u; pw.w = 0u; }
            const bf16x8 pf = __builtin_bit_cast(bf16x8, pw);
#pragma unroll
            for (int dt = 0; dt < 4; ++dt) {
                const bf16_t* vr = Vt + (dt * 16 + fr) * VTP + (kt0 + 2 * kk) * 16 + fq * 4;
                u32x4 vw; const u32x2 v0 = *(const u32x2*)vr, v1 = *(const u32x2*)(vr + 16); vw.x = v0.x; vw.y = v0.y; vw.z = v1.x; vw.w = v1.y;
                o[dt] = __builtin_amdgcn_mfma_f32_16x16x32_bf16(__builtin_bit_cast(bf16x8, vw), pf, o[dt], 0, 0, 0);
            }
        }
        bf16_t* qrow = qrow0 + (size_t)qt * 16 * LDZ;
#pragma unroll
        for (int dt = 0; dt < 4; ++dt) { u32x2 w; w.x = cvt_pk_bf16(o[dt][0] * rl, o[dt][1] * rl); w.y = cvt_pk_bf16(o[dt][2] * rl, o[dt][3] * rl); *(u32x2*)(qrow + dt * 16 + fq * 4) = w; }
    }
    __syncthreads();
}

__device__ __forceinline__ void stage_tile64x128(bf16_t* dst  , const bf16_t* src  , int tid) {
#pragma unroll
    for (int i = 0; i < 2; ++i) { const int chunk = tid + 512 * i; const int s = chunk >> 4, part = chunk & 15;
        *(u32x4*)(dst + s * 136 + part * 8) = *(const u32x4*)(src + (size_t)s * LDZ + part * 8); }
}
__device__ __forceinline__ void stage_vt(bf16_t* Vt  , const bf16_t* src, int tid) {
    constexpr int SP = 72;
#pragma unroll
    for (int i = 0; i < 2; ++i) { const int chunk = tid + 512 * i; const int s = chunk >> 4, part = chunk & 15;
        const u32x4 vv = *(const u32x4*)(src + (size_t)s * LDZ + part * 8);
        bf16_t* vd = Vt + (part * 8) * SP + (s ^ ((part & 7) << 3));
        vd[0 * SP] = (bf16_t)(vv.x & 0xffffu); vd[1 * SP] = (bf16_t)(vv.x >> 16); vd[2 * SP] = (bf16_t)(vv.y & 0xffffu); vd[3 * SP] = (bf16_t)(vv.y >> 16);
        vd[4 * SP] = (bf16_t)(vv.z & 0xffffu); vd[5 * SP] = (bf16_t)(vv.z >> 16); vd[6 * SP] = (bf16_t)(vv.w & 0xffffu); vd[7 * SP] = (bf16_t)(vv.w >> 16); }
}
__device__ __forceinline__ float gate_cumsum(float (&gl)[32], float (&ky)[32], int dir) {
#pragma unroll
    for (int i = 0; i < 32; ++i) ky[i] = 1.0f - __expf(gl[i]);
    float run = 0.f;
    if (dir == 0) {
#pragma unroll
        for (int i = 0; i < 32; ++i) { run += gl[i]; gl[i] = run; }
    } else {
#pragma unroll
        for (int i = 31; i >= 0; --i) { run += gl[i]; gl[i] = run; }
    }
    return run;
}
__device__ __forceinline__ void hgrn_pass1_unit(const Ctx& c, const bf16_t* Z, bf16_t* Lg, float* DEC, float* ENR, int unit) {
    constexpr int SP = 72, QP = 136;
    bf16_t* Raw = (bf16_t*)c.lds;
    bf16_t* KdT = (bf16_t*)c.lds;
    bf16_t* Vt = (bf16_t*)(c.lds + 2 * 128 * SP * 2);
    float* tot = (float*)(c.lds + 3 * 128 * SP * 2);
    const int ch = unit & 127, h = (unit >> 7) & 3, b = unit >> 9;
    const size_t row0 = (size_t)b * SEQ + (size_t)ch * 64;
    const int dir = c.tid >> 8, half = (c.tid >> 7) & 1, k = c.tid & 127;
    const bf16_t* zt = Z + row0 * LDZ + h * 128;
    stage_tile64x128(Raw, zt + ZFF, c.tid); stage_tile64x128(Raw + 64 * QP, zt + ZFB, c.tid); stage_vt(Vt, zt + ZI, c.tid);
    __syncthreads();
    float gl[32], ky[32];
    {
        const bf16_t* zr = Raw + (dir * 64 + half * 32) * QP + k;
#pragma unroll
        for (int i = 0; i < 32; ++i) gl[i] = bf2f(zr[i * QP]);
    }
    const float run = gate_cumsum(gl, ky, dir);
    tot[(dir * 2 + half) * 128 + k] = run;
    __syncthreads();
    const bool near = (half == dir);
    const float tother = tot[(dir * 2 + (half ^ 1)) * 128 + k];
    const float add = run + (near ? tother : 0.f);
    if (near) { const size_t di = ((size_t)((dir * 16 + b * 4 + h) * 128 + (dir ? 127 - ch : ch))) * 128 + k; DEC[di] = __expf(run + tother); ENR[di] = __expf(run); }
    {
        unsigned pkd[16];
#pragma unroll
        for (int i = 0; i < 32; i += 2) pkd[i >> 1] = cvt_pk_bf16(ky[i] * __expf(add - gl[i]), ky[i + 1] * __expf(add - gl[i + 1]));
        u32x4* dst = (u32x4*)(KdT + (dir * 128 + k) * SP + half * 32);
#pragma unroll
        for (int w = 0; w < 4; ++w) dst[w] = (u32x4){pkd[4 * w], pkd[4 * w + 1], pkd[4 * w + 2], pkd[4 * w + 3]};
    }
    __syncthreads();
    {
        const int fr = c.lane & 15, fq = c.lane >> 4;
        const int wd = c.wave >> 2, kq = c.wave & 3;
        bf16_t* Lo = Lg + ((size_t)((wd * 16 + b * 4 + h) * 128 + (wd ? 127 - ch : ch))) * 128 * 128;
#pragma unroll
        for (int kt = 0; kt < 2; ++kt) {
            const bf16_t* ar = KdT + (wd * 128 + kq * 32 + kt * 16 + fr) * SP + fq * 8;
            const bf16x8 a0 = *(const bf16x8*)ar, a1 = *(const bf16x8*)(ar + 32);
#pragma unroll
            for (int vt = 0; vt < 8; ++vt) {
                const int vx = (((vt * 16 + fr) >> 3) & 7) << 3;
                const bf16_t* br = Vt + (vt * 16 + fr) * SP;
                f32x4 acc = (f32x4){0.f, 0.f, 0.f, 0.f};
                acc = __builtin_amdgcn_mfma_f32_16x16x32_bf16(a0, *(const bf16x8*)(br + ((fq * 8) ^ vx)), acc, 0, 0, 0);
                acc = __builtin_amdgcn_mfma_f32_16x16x32_bf16(a1, *(const bf16x8*)(br + ((fq * 8 + 32) ^ vx)), acc, 0, 0, 0);
                u32x2 w; w.x = cvt_pk_bf16(acc[0], acc[1]); w.y = cvt_pk_bf16(acc[2], acc[3]);
                *(u32x2*)(Lo + (size_t)(vt * 16 + fr) * 128 + kq * 32 + kt * 16 + fq * 4) = w;
            }
        }
    }
    __syncthreads();
}

__device__ __forceinline__ void hgrn_scan(const Ctx& c, bf16_t* Lg, const float* DEC, const float* ENR) {
    for (int idx = c.bid * 512 + c.tid; idx < 32 * 128 * 32; idx += c.G * 512) {
        const int k4 = idx & 31, v = (idx >> 5) & 127, seq = idx >> 12;
        bf16_t* lp = Lg + (size_t)seq * 128 * 16384 + (size_t)v * 128 + k4 * 4;
        const float* dp = DEC + (size_t)seq * 128 * 128 + k4 * 4;
        const float* ep = ENR + (size_t)seq * 128 * 128 + k4 * 4;
        f32x4 st = (f32x4){0.f, 0.f, 0.f, 0.f};
#pragma unroll 1
        for (int c0 = 0; c0 < 128; c0 += 8) {
            u32x2 lw[8]; f32x4 dd[8], ee[8];
#pragma unroll
            for (int i = 0; i < 8; ++i) { lw[i] = *(const u32x2*)(lp + (size_t)(c0 + i) * 16384); dd[i] = *(const f32x4*)(dp + (size_t)(c0 + i) * 128); ee[i] = *(const f32x4*)(ep + (size_t)(c0 + i) * 128); }
#pragma unroll
            for (int i = 0; i < 8; ++i) {
                u32x2 o; o.x = cvt_pk_bf16(st[0] * ee[i][0], st[1] * ee[i][1]); o.y = cvt_pk_bf16(st[2] * ee[i][2], st[3] * ee[i][3]);
                *(u32x2*)(lp + (size_t)(c0 + i) * 16384) = o;
                st[0] = dd[i][0] * st[0] + bf_lo(lw[i].x); st[1] = dd[i][1] * st[1] + bf_hi(lw[i].x); st[2] = dd[i][2] * st[2] + bf_lo(lw[i].y); st[3] = dd[i][3] * st[3] + bf_hi(lw[i].y);
            }
        }
    }
}

__device__ __forceinline__ void hgrn_pass3_unit(const Ctx& c, bf16_t* Z, const float* a_norm, const bf16_t* Lg, int unit, int ocol) {
    constexpr int QP = 136, SP = 72;
    bf16_t* Qp = (bf16_t*)c.lds;
    bf16_t* Kp = Qp + 2 * 64 * QP;
    bf16_t* Vt = Kp + 2 * 64 * QP;
    float* tot = (float*)(Vt + 128 * SP);
    float* red = tot + 512;
    const int ch = unit & 127, h = (unit >> 7) & 3, b = unit >> 9;
    const size_t row0 = (size_t)b * SEQ + (size_t)ch * 64;
    {
        const int dir = c.tid >> 8, half = (c.tid >> 7) & 1, k = c.tid & 127;
        const bf16_t* zt = Z + row0 * LDZ + h * 128;
        stage_tile64x128(Qp, zt + ZFF, c.tid); stage_tile64x128(Qp + 64 * QP, zt + ZFB, c.tid); stage_tile64x128(Kp, zt + ZQ, c.tid); stage_vt(Vt, zt + ZI, c.tid);
        __syncthreads();
        float gl[32], ky[32], qv[32];
        {
            const bf16_t* zr = Qp + (dir * 64 + half * 32) * QP + k; const bf16_t* qr = Kp + (half * 32) * QP + k;
#pragma unroll
            for (int i = 0; i < 32; ++i) { gl[i] = bf2f(zr[i * QP]); qv[i] = bf2f(qr[i * QP]); }
        }
        const float run = gate_cumsum(gl, ky, dir);
        __syncthreads();
        const float rsub = (half == dir) ? run : 0.f;
        bf16_t* qpd = Qp + (dir * 64 + half * 32) * QP + k; bf16_t* kpd = Kp + (dir * 64 + half * 32) * QP + k;
#pragma unroll
        for (int i = 0; i < 32; ++i) {
            const float e = __expf(gl[i] - rsub);
            qpd[i * QP] = f2bf(qv[i] * e);
            kpd[i * QP] = f2bf(ky[i] * __builtin_amdgcn_rcpf(e));
        }
    }
    const int fr = c.lane & 15, fq = c.lane >> 4;
    const int tt = c.wave & 3, vh = c.wave >> 2;
    bf16x8 sf[2][4][4];
#pragma unroll
    for (int dir = 0; dir < 2; ++dir) {
        const bf16_t* Sg = Lg + ((size_t)((dir * 16 + b * 4 + h) * 128 + (dir ? 127 - ch : ch))) * 16384;
#pragma unroll
        for (int vt = 0; vt < 4; ++vt)
#pragma unroll
            for (int ks = 0; ks < 4; ++ks) sf[dir][vt][ks] = *(const bf16x8*)(Sg + (size_t)((vh * 4 + vt) * 16 + fr) * 128 + fq * 8 + ks * 32);
    }
    bf16_t* grow = Z + (row0 + tt * 16 + fr) * LDZ + ZG + h * 128;
    u32x2 gwv[4];
#pragma unroll
    for (int vt = 0; vt < 4; ++vt) gwv[vt] = *(const u32x2*)(grow + (vh * 4 + vt) * 16 + fq * 4);
    __syncthreads();
    f32x4 acc[4];
#pragma unroll
    for (int vt = 0; vt < 4; ++vt) acc[vt] = (f32x4){0.f, 0.f, 0.f, 0.f};
#pragma unroll
    for (int dir = 0; dir < 2; ++dir) {
        bf16x8 qf[4];
#pragma unroll
        for (int ks = 0; ks < 4; ++ks) qf[ks] = *(const bf16x8*)(Qp + (size_t)(dir * 64 + tt * 16 + fr) * QP + ks * 32 + fq * 8);
        f32x4 at[4];
#pragma unroll
        for (int st = 0; st < 4; ++st) {
            f32x4 a = (f32x4){0.f, 0.f, 0.f, 0.f};
            const bf16_t* kr = Kp + (size_t)(dir * 64 + st * 16 + fr) * QP + fq * 8;
#pragma unroll
            for (int ks = 0; ks < 4; ++ks) a = __builtin_amdgcn_mfma_f32_16x16x32_bf16(*(const bf16x8*)(kr + ks * 32), qf[ks], a, 0, 0, 0);
#pragma unroll
            for (int j = 0; j < 4; ++j) { const int s = st * 16 + fq * 4 + j, t = tt * 16 + fr; const bool ok = dir ? (s >= t) : (s <= t); a[j] = ok ? a[j] : 0.f; }
            at[st] = a;
        }
#pragma unroll
        for (int kk = 0; kk < 2; ++kk) {
            u32x4 pw; pw.x = cvt_pk_bf16(at[2 * kk][0], at[2 * kk][1]); pw.y = cvt_pk_bf16(at[2 * kk][2], at[2 * kk][3]); pw.z = cvt_pk_bf16(at[2 * kk + 1][0], at[2 * kk + 1][1]); pw.w = cvt_pk_bf16(at[2 * kk + 1][2], at[2 * kk + 1][3]);
            const bf16x8 pf = __builtin_bit_cast(bf16x8, pw);
#pragma unroll
            for (int vt = 0; vt < 4; ++vt) {
                const int vx = ((((vh * 4 + vt) * 16 + fr) >> 3) & 7) << 3, vc = (2 * kk) * 16 + fq * 4; const bf16_t* vrow = Vt + (size_t)((vh * 4 + vt) * 16 + fr) * SP;
                u32x4 vw; const u32x2 v0 = *(const u32x2*)(vrow + (vc ^ vx)), v1 = *(const u32x2*)(vrow + ((vc + 16) ^ vx)); vw.x = v0.x; vw.y = v0.y; vw.z = v1.x; vw.w = v1.y;
                acc[vt] = __builtin_amdgcn_mfma_f32_16x16x32_bf16(__builtin_bit_cast(bf16x8, vw), pf, acc[vt], 0, 0, 0);
            }
        }
        if (A_MASK & 2) {
#pragma unroll
        for (int vt = 0; vt < 4; ++vt)
#pragma unroll
            for (int ks = 0; ks < 4; ++ks) acc[vt] = __builtin_amdgcn_mfma_f32_16x16x32_bf16(sf[dir][vt][ks], qf[ks], acc[vt], 0, 0, 0);
        }
    }
    float ss = 0.f;
#pragma unroll
    for (int vt = 0; vt < 4; ++vt) ss += (acc[vt][0] * acc[vt][0] + acc[vt][1] * acc[vt][1]) + (acc[vt][2] * acc[vt][2] + acc[vt][3] * acc[vt][3]);
    ss += __shfl_xor(ss, 16); ss += __shfl_xor(ss, 32);
    if (fq == 0) red[vh * 64 + tt * 16 + fr] = ss;
    __syncthreads();
    const float rstd = rsqrtf((red[tt * 16 + fr] + red[64 + tt * 16 + fr]) * (1.f / 128.f) + EPS);
#pragma unroll
    for (int vt = 0; vt < 4; ++vt) {
        const int v0 = (vh * 4 + vt) * 16 + fq * 4;
        const u32x2 gw = gwv[vt];
        const f32x4 nw = *(const f32x4*)(a_norm + v0);
        const float g0 = bf_lo(gw.x), g1 = bf_hi(gw.x), g2 = bf_lo(gw.y), g3 = bf_hi(gw.y);
        u32x2 o;
        o.x = cvt_pk_bf16(acc[vt][0] * rstd * nw[0] * g0 * sigmoidf_(g0), acc[vt][1] * rstd * nw[1] * g1 * sigmoidf_(g1));
        o.y = cvt_pk_bf16(acc[vt][2] * rstd * nw[2] * g2 * sigmoidf_(g2), acc[vt][3] * rstd * nw[3] * g3 * sigmoidf_(g3));
        *(u32x2*)(grow + v0 + (ocol - ZG)) = o;
    }
    __syncthreads();
}

__device__ __forceinline__ void p3_issue_raw(unsigned char* lds_raw_, const bf16_t* Z, int unit, int tid, int wave, u32x4 (&vreg)[2]) {
    constexpr int RAWB = 91136;
    const int ch = unit & 127, h = (unit >> 7) & 3, b = unit >> 9;
    const bf16_t* zt = Z + ((size_t)b * SEQ + (size_t)ch * 64) * LDZ + h * 128;
    LAS unsigned char* l3 = (LAS unsigned char*)lds_raw_ + RAWB;
#pragma unroll
    for (int i = 0; i < 2; ++i) { const int chunk = tid + 512 * i; const bf16_t* p = zt + (size_t)(chunk >> 4) * LDZ + (chunk & 15) * 8;
        __builtin_amdgcn_global_load_lds((const unsigned*)(p + ZFF), (LAS unsigned*)(l3 + 0 * 16384 + i * 8192 + wave * 1024), 16, 0, 0);
        __builtin_amdgcn_global_load_lds((const unsigned*)(p + ZFB), (LAS unsigned*)(l3 + 1 * 16384 + i * 8192 + wave * 1024), 16, 0, 0);
        __builtin_amdgcn_global_load_lds((const unsigned*)(p + ZQ),  (LAS unsigned*)(l3 + 2 * 16384 + i * 8192 + wave * 1024), 16, 0, 0);
        vreg[i] = *(const u32x4*)(p + ZI); }
}
#define LDS_BAR() do { asm volatile("s_waitcnt lgkmcnt(0)" ::: "memory"); __builtin_amdgcn_s_barrier(); asm volatile("" ::: "memory"); } while (0)
__device__ __forceinline__ void hgrn_pass3_phase(unsigned char* lds_raw_, bf16_t* Z, const float* a_norm, const bf16_t* Lg, int bid, int G, int ocol) {
    constexpr int QP = 136, SP = 72, RAWB = 91136;
    bf16_t* Qp = (bf16_t*)lds_raw_;
    bf16_t* Kp = Qp + 2 * 64 * QP;
    bf16_t* Vt = Kp + 2 * 64 * QP;
    float* red = (float*)(Vt + 128 * SP) + 512;
    const bf16_t* Raw = (const bf16_t*)(lds_raw_ + RAWB);
    u32x4 vreg[2];
    { const Ctx c0 = make_ctx(lds_raw_); if (bid < 2048) p3_issue_raw(lds_raw_, Z, bid, c0.tid, c0.wave, vreg); }
#pragma unroll 1
    for (int unit = bid; unit < 2048; unit += G) {
        const Ctx c = make_ctx(lds_raw_);
        const int ch = unit & 127, h = (unit >> 7) & 3, b = unit >> 9;
        const size_t row0 = (size_t)b * SEQ + (size_t)ch * 64;
#pragma unroll
        for (int i = 0; i < 2; ++i) { const int chunk = c.tid + 512 * i; const int s = chunk >> 4, part = chunk & 15;
            const u32x4 vv = vreg[i]; bf16_t* vd = Vt + (part * 8) * SP + (s ^ ((part & 7) << 3));
            vd[0 * SP] = (bf16_t)(vv.x & 0xffffu); vd[1 * SP] = (bf16_t)(vv.x >> 16); vd[2 * SP] = (bf16_t)(vv.y & 0xffffu); vd[3 * SP] = (bf16_t)(vv.y >> 16);
            vd[4 * SP] = (bf16_t)(vv.z & 0xffffu); vd[5 * SP] = (bf16_t)(vv.z >> 16); vd[6 * SP] = (bf16_t)(vv.w & 0xffffu); vd[7 * SP] = (bf16_t)(vv.w >> 16); }
        asm volatile("s_waitcnt vmcnt(0)" ::: "memory");
        __syncthreads();
        {
            const int dir = c.tid >> 8, half = (c.tid >> 7) & 1, k = c.tid & 127;
            float gl[32], ky[32], qv[32];
            {
                const bf16_t* zr = Raw + (dir * 64 + half * 32) * 128 + k; const bf16_t* qr = Raw + (128 + half * 32) * 128 + k;
#pragma unroll
                for (int i = 0; i < 32; ++i) { gl[i] = bf2f(zr[i * 128]); qv[i] = bf2f(qr[i * 128]); }
            }
            const float run = gate_cumsum(gl, ky, dir);
            const float rsub = (half == dir) ? run : 0.f;
            bf16_t* qpd = Qp + (dir * 64 + half * 32) * QP + k; bf16_t* kpd = Kp + (dir * 64 + half * 32) * QP + k;
#pragma unroll
            for (int i = 0; i < 32; ++i) {
                const float e = __expf(gl[i] - rsub);
                qpd[i * QP] = f2bf(qv[i] * e);
                kpd[i * QP] = f2bf(ky[i] * __builtin_amdgcn_rcpf(e));
            }
        }
        const int fr = c.lane & 15, fq = c.lane >> 4;
        const int tt = c.wave & 3, vh = c.wave >> 2;
        bf16x8 sf[2][4][4];
#pragma unroll
        for (int dir = 0; dir < 2; ++dir) {
            const bf16_t* Sg = Lg + ((size_t)((dir * 16 + b * 4 + h) * 128 + (dir ? 127 - ch : ch))) * 16384;
#pragma unroll
            for (int vt = 0; vt < 4; ++vt)
#pragma unroll
                for (int ks = 0; ks < 4; ++ks) sf[dir][vt][ks] = *(const bf16x8*)(Sg + (size_t)((vh * 4 + vt) * 16 + fr) * 128 + fq * 8 + ks * 32);
        }
        bf16_t* grow = Z + (row0 + tt * 16 + fr) * LDZ + ZG + h * 128;
        u32x2 gwv[4];
#pragma unroll
        for (int vt = 0; vt < 4; ++vt) gwv[vt] = *(const u32x2*)(grow + (vh * 4 + vt) * 16 + fq * 4);
        LDS_BAR();
        if (unit + G < 2048) p3_issue_raw(lds_raw_, Z, unit + G, c.tid, c.wave, vreg);
        f32x4 acc[4];
#pragma unroll
        for (int vt = 0; vt < 4; ++vt) acc[vt] = (f32x4){0.f, 0.f, 0.f, 0.f};
#pragma unroll
        for (int dir = 0; dir < 2; ++dir) {
            bf16x8 qf[4];
#pragma unroll
            for (int ks = 0; ks < 4; ++ks) qf[ks] = *(const bf16x8*)(Qp + (size_t)(dir * 64 + tt * 16 + fr) * QP + ks * 32 + fq * 8);
            f32x4 at[4];
#pragma unroll
            for (int st = 0; st < 4; ++st) {
                f32x4 a = (f32x4){0.f, 0.f, 0.f, 0.f};
                const bf16_t* kr = Kp + (size_t)(dir * 64 + st * 16 + fr) * QP + fq * 8;
#pragma unroll
                for (int ks = 0; ks < 4; ++ks) a = __builtin_amdgcn_mfma_f32_16x16x32_bf16(*(const bf16x8*)(kr + ks * 32), qf[ks], a, 0, 0, 0);
#pragma unroll
                for (int j = 0; j < 4; ++j) { const int s = st * 16 + fq * 4 + j, t = tt * 16 + fr; const bool ok = dir ? (s >= t) : (s <= t); a[j] = ok ? a[j] : 0.f; }
                at[st] = a;
            }
#pragma unroll
            for (int kk = 0; kk < 2; ++kk) {
                u32x4 pw; pw.x = cvt_pk_bf16(at[2 * kk][0], at[2 * kk][1]); pw.y = cvt_pk_bf16(at[2 * kk][2], at[2 * kk][3]); pw.z = cvt_pk_bf16(at[2 * kk + 1][0], at[2 * kk + 1][1]); pw.w = cvt_pk_bf16(at[2 * kk + 1][2], at[2 * kk + 1][3]);
                const bf16x8 pf = __builtin_bit_cast(bf16x8, pw);
#pragma unroll
                for (int vt = 0; vt < 4; ++vt) {
                    const int vx = ((((vh * 4 + vt) * 16 + fr) >> 3) & 7) << 3, vc = (2 * kk) * 16 + fq * 4; const bf16_t* vrow = Vt + (size_t)((vh * 4 + vt) * 16 + fr) * SP;
                    u32x4 vw; const u32x2 v0 = *(const u32x2*)(vrow + (vc ^ vx)), v1 = *(const u32x2*)(vrow + ((vc + 16) ^ vx)); vw.x = v0.x; vw.y = v0.y; vw.z = v1.x; vw.w = v1.y;
                    acc[vt] = __builtin_amdgcn_mfma_f32_16x16x32_bf16(__builtin_bit_cast(bf16x8, vw), pf, acc[vt], 0, 0, 0);
                }
            }
            if (A_MASK & 2) {
#pragma unroll
            for (int vt = 0; vt < 4; ++vt)
#pragma unroll
                for (int ks = 0; ks < 4; ++ks) acc[vt] = __builtin_amdgcn_mfma_f32_16x16x32_bf16(sf[dir][vt][ks], qf[ks], acc[vt], 0, 0, 0);
            }
        }
        float ss = 0.f;
#pragma unroll
        for (int vt = 0; vt < 4; ++vt) ss += (acc[vt][0] * acc[vt][0] + acc[vt][1] * acc[vt][1]) + (acc[vt][2] * acc[vt][2] + acc[vt][3] * acc[vt][3]);
        ss += __shfl_xor(ss, 16); ss += __shfl_xor(ss, 32);
        if (fq == 0) red[vh * 64 + tt * 16 + fr] = ss;
        LDS_BAR();
        const float rstd = rsqrtf((red[tt * 16 + fr] + red[64 + tt * 16 + fr]) * (1.f / 128.f) + EPS);
#pragma unroll
        for (int vt = 0; vt < 4; ++vt) {
            const int v0 = (vh * 4 + vt) * 16 + fq * 4;
            const u32x2 gw = gwv[vt];
            const f32x4 nw = *(const f32x4*)(a_norm + v0);
            const float g0 = bf_lo(gw.x), g1 = bf_hi(gw.x), g2 = bf_lo(gw.y), g3 = bf_hi(gw.y);
            u32x2 o;
            o.x = cvt_pk_bf16(acc[vt][0] * rstd * nw[0] * g0 * sigmoidf_(g0), acc[vt][1] * rstd * nw[1] * g1 * sigmoidf_(g1));
            o.y = cvt_pk_bf16(acc[vt][2] * rstd * nw[2] * g2 * sigmoidf_(g2), acc[vt][3] * rstd * nw[3] * g3 * sigmoidf_(g3));
            *(u32x2*)(grow + v0 + (ocol - ZG)) = o;
        }
        LDS_BAR();
    }
}

#define XB_TMO      128
#define XB_XCNT(j)  (256  + 64 * (j))
#define XB_XSUB(j)  (1280 + 64 * (j))
#define XB_XGEN(j)  (2304 + 64 * (j))
#define XB_TOP      3328
#define XB_TOPGEN   3392
#define XCD_BAR_WORDS 3456
#define XB_SPIN_CAP (1u << 20)
constexpr size_t WS_BAR = 896 * 1024;
constexpr int LDS_MISC_OFF = LDS_BYTES - 64;
__device__ __forceinline__ unsigned xb_ld(unsigned* p)              { return __hip_atomic_load(p, __ATOMIC_RELAXED, __HIP_MEMORY_SCOPE_AGENT); }
__device__ __forceinline__ unsigned xb_add(unsigned* p, unsigned v) { return __hip_atomic_fetch_add(p, v, __ATOMIC_RELAXED, __HIP_MEMORY_SCOPE_AGENT); }
__device__ __forceinline__ unsigned xb_xcc_id() { return (unsigned)__builtin_amdgcn_s_getreg((3 << 11) | 20) & 0xFu; }
#define XB_SPIN(cond, bar) do { unsigned _sp = 0; while (cond) { __builtin_amdgcn_s_sleep(1); \
    if ((++_sp & 255u) == 0u) { if (xb_ld(&(bar)[XB_TMO])) break; if (_sp > XB_SPIN_CAP) { atomicAdd(&(bar)[XB_TMO], 1u); break; } } } } while (0)
struct XcdBarrier { unsigned* bar; unsigned x; volatile LAS unsigned* st; };
__device__ __forceinline__ XcdBarrier xcd_barrier_post(unsigned* bar, volatile LAS unsigned* st) {
    XcdBarrier b; b.bar = bar; b.x = xb_xcc_id(); b.st = st;
    if (threadIdx.x == 0) (void)xb_add(&bar[XB_XCNT(b.x)], 1u);
    return b;
}
__device__ __forceinline__ void xcd_barrier_complete(unsigned* bar, unsigned x, unsigned& nloc, unsigned& nx) {
    const unsigned G = gridDim.x * gridDim.y * gridDim.z;
    unsigned sum, cnt, mine, sp = 0u;
    for (;;) {
        sum = 0u; cnt = 0u; mine = 0u;
#pragma unroll
        for (unsigned j = 0; j < 16; ++j) { const unsigned c = xb_ld(&bar[XB_XCNT(j)]); sum += c; cnt += (c > 0u) ? 1u : 0u; mine = (j == x) ? c : mine; }
        if (sum == G) break;
        __builtin_amdgcn_s_sleep(1);
        if ((++sp & 255u) == 0u) { if (xb_ld(&bar[XB_TMO])) break; if (sp > XB_SPIN_CAP) { atomicAdd(&bar[XB_TMO], 1u); break; } }
    }
    nloc = mine > 0u ? mine : 1u; nx = cnt > 0u ? cnt : 1u;
}
__device__ __forceinline__ void xcd_barrier(const XcdBarrier& b) {
    asm volatile("s_waitcnt vmcnt(0)" ::: "memory");
    __syncthreads();
    if (threadIdx.x == 0) {
        unsigned* bar = b.bar;
        __builtin_amdgcn_s_waitcnt(0);
        unsigned nloc = b.st[0], nx = b.st[1];
        if (nloc == 0u) { xcd_barrier_complete(bar, b.x, nloc, nx); b.st[0] = nloc; b.st[1] = nx; }
        const unsigned old = xb_add(&bar[XB_XSUB(b.x)], 1u);
        const unsigned gen = old / nloc;
        if (old + 1u == (gen + 1u) * nloc) {
            __builtin_amdgcn_fence(__ATOMIC_RELEASE, "agent");
            asm volatile("s_waitcnt vmcnt(0)" ::: "memory");
            const unsigned og = xb_add(&bar[XB_TOP], 1u);
            const unsigned tg = og / nx;
            if (og + 1u == (tg + 1u) * nx) xb_add(&bar[XB_TOPGEN], 1u);
            else XB_SPIN(xb_ld(&bar[XB_TOPGEN]) == tg, bar);
            __builtin_amdgcn_fence(__ATOMIC_ACQUIRE, "agent");
            xb_add(&bar[XB_XGEN(b.x)], 1u);
            asm volatile("s_waitcnt vmcnt(0)" ::: "memory");
        } else {
            XB_SPIN(xb_ld(&bar[XB_XGEN(b.x)]) == gen, bar);
            __builtin_amdgcn_fence(__ATOMIC_ACQUIRE, "agent");
            asm volatile("s_waitcnt vmcnt(0)" ::: "memory");
        }
    }
    __syncthreads();
}

struct Args { const float* in[14]; float* out; unsigned char* ws; int ph_lo, ph_hi; };
typedef __attribute__((address_space(4))) const unsigned long long* kargp_t;
__device__ __forceinline__ kargp_t kargs_now() { kargp_t p = (kargp_t)__builtin_amdgcn_kernarg_segment_ptr(); asm volatile("" : "+s"(p)); return p; }
#define GAS1 __attribute__((address_space(1)))
#define KIN(i) ((const float*)(const GAS1 float*)ka[i])
#define KOUT ((float*)(GAS1 float*)ka[14])
#define KWS ((unsigned char*)(GAS1 unsigned char*)ka[15])

__global__ void __launch_bounds__(512, 2) fwd_megakernel(Args a) {
    extern __shared__ __attribute__((aligned(16))) unsigned char lds_raw[];
    LAS unsigned char* ldsl = (LAS unsigned char*)lds_raw;
    const int ph_lo = a.ph_lo, ph_hi = a.ph_hi;
    XcdBarrier xbar; xbar.bar = (unsigned*)(a.ws + WS_BAR); xbar.x = 0; xbar.st = (volatile LAS unsigned*)(ldsl + LDS_MISC_OFF);
    if (USE_XB) {
        if (threadIdx.x < 16) ((LAS unsigned*)(ldsl + LDS_MISC_OFF))[threadIdx.x] = 0u;
        if (blockIdx.x == 0) for (int i = threadIdx.x; i < 4096; i += 512) ((unsigned*)(a.ws + WS_BAR))[i] = 0u;
        __syncthreads();
    }
    for (int ph = ph_lo; ph < ph_hi; ++ph) {
        if (ph > ph_lo) { if (USE_XB && ph > ph_lo + 1) { xcd_barrier(xbar); } else { cg::this_grid().sync(); if (USE_XB) xbar = xcd_barrier_post((unsigned*)(a.ws + WS_BAR), (volatile LAS unsigned*)(ldsl + LDS_MISC_OFF)); } }
        const Ctx c = make_ctx(lds_raw);
        const kargp_t ka = kargs_now();
        unsigned char* ws = KWS;
        bf16_t* Z = (bf16_t*)(ws + WS_Z);
        bf16_t* Wb = (bf16_t*)(ws + WS_W);
        bf16_t* Lg = (bf16_t*)(ws + WS_L);
        float* DEC = (float*)(ws + WS_DEC);
        if (ph == NPH - 1) { if (PHON(10)) rms_rows_f32_inplace(c, KOUT, KIN(13)); continue; }
        const int nrep = DUP_THIN ? 2 : 1;
        const int l = ph / 9, k9 = ph % 9; const int k = k9 < 7 ? k9 : k9 + 1;
        if (k == 0 && PHON(0)) {
            for (int rep = 0; rep < nrep; ++rep) phase_pre(c, l, KIN(1), KIN(2), KIN(3), KIN(5), KIN(8), KIN(9), KIN(10), KIN(11), KIN(12), l == 0 ? KIN(0) : KOUT, ws);
            __syncthreads();
        } else if (k == 1 && PHON(1)) {
            pg8::Gemm g{Z + ZXN, (const bf16_t*)((const char*)Wb + W_IN), T, NZ, D, LDZ}; pg8::StaticOrder S; S.init(T, NZ, c.G, c.bid);
            pg8::EpiZ E{Z, LDZ, (const float*)(ws + WS_LOW), (const f32x2*)(ws + WS_ROPE)};
            if (DUP_GEMM) pg8::gemm_phase<pg8::EpiZ>(ldsl, g, S, E, c.tid);
            pg8::gemm_phase<pg8::EpiZ>(ldsl, g, S, E, c.tid);
        } else if (k == 2 && PHON(2)) {
            const float* lbl = KIN(3);
            for (int u = c.bid; u < 512 + 256 + 2048; u += c.G) {
                const Ctx c = make_ctx(lds_raw);
                if (u < 512) { if (BR_MASK & 1) branch_c_unit(c, Z, KIN(7) + l * 8, u); }
                else if (u < 768) { if (BR_MASK & 2) branch_b_unit(c, Z, (const bf16_t*)(ws + WS_WSB), KIN(6) + (size_t)l * 512, u - 512); }
                else if (BR_MASK & 4) { if (DUP_P1) hgrn_pass1_unit(c, Z, Lg, DEC, (float*)(ws + WS_ENR), u - 768); hgrn_pass1_unit(c, Z, Lg, DEC, (float*)(ws + WS_ENR), u - 768); }
            }
        } else if (k == 3 && PHON(3)) {
            hgrn_scan(c, Lg, DEC, (const float*)(ws + WS_ENR));
        } else if (k == 4 && PHON(4)) {
            hgrn_pass3_phase(lds_raw, Z, KIN(4) + (size_t)l * 128, Lg, c.bid, c.G, ZG);
        } else if (k == 5 && PHON(5)) {
            bf16_t* Mg = (bf16_t*)(ws + WS_MERGED); unsigned char* Sg = (unsigned char*)(ws + WS_SST);
            pg8::StaticOrder S; S.init(T, D, c.G, c.bid);
#pragma unroll 1
            for (int rep = 0; rep < 1 + DUP_GEMM; ++rep)
#pragma unroll 1
            for (int b = 0; b < 3; ++b) {
                pg8::Gemm gg{Z + ZXN, (const bf16_t*)((const char*)Wb + W_IN) + (size_t)(NZ + b * D) * D, T, D, D, LDZ};
                pg8::EpiSig8 Eg{Sg, D};
                { const Ctx c2 = make_ctx(lds_raw); pg8::gemm_phase<pg8::EpiSig8>(ldsl, gg, S, Eg, c2.tid); }
                const int ycol = b == 0 ? ZG : (b == 1 ? ZU : ZCQ);
                pg8::Gemm gp{Z + ycol, (const bf16_t*)((const char*)Wb + W_BR) + (size_t)b * D * 512, T, D, 512, LDZ};
                const Ctx c3 = make_ctx(lds_raw);
                if (b == 0) { pg8::EpiMul<0> Em{Mg, Sg, D}; pg8::gemm_phase<pg8::EpiMul<0>>(ldsl, gp, S, Em, c3.tid); }
                else { pg8::EpiMul<1> Em{Mg, Sg, D}; pg8::gemm_phase<pg8::EpiMul<1>>(ldsl, gp, S, Em, c3.tid); }
            }
        } else if (k == 6 && PHON(6)) {
            pg8::Gemm g{(const bf16_t*)(ws + WS_MERGED), (const bf16_t*)((const char*)Wb + W_OUT), T, D, D, D}; pg8::StaticOrder S; S.init(T, D, c.G, c.bid);
            pg8::EpiRes<true> E{KIN(0), KOUT, D, (bf16_t*)(ws + WS_SST), (float*)(ws + WS_SUMSQ), l == 0 ? nullptr : (bf16_t*)KOUT};
            pg8::gemm_phase<pg8::EpiRes<true>>(ldsl, g, S, E, c.tid);
        } else if (k == 7 && PHON(7)) {
            for (int rep = 0; rep < nrep; ++rep) rms_rows_bf16(c, KOUT, KIN(10) + (size_t)l * D, (bf16_t*)(ws + WS_HN), D);
        } else if (k == 8 && PHON(8)) {
            pg8::Gemm g{(const bf16_t*)(ws + WS_SST), (const bf16_t*)((const char*)Wb + W_UP), T, DFF, D, D}; pg8::StaticOrder S; S.init(T, DFF, c.G, c.bid);
            pg8::EpiAct<1> E{Z, DFF, (const float*)(ws + WS_SUMSQ)};
            pg8::gemm_phase<pg8::EpiAct<1>>(ldsl, g, S, E, c.tid);
        } else if (k == 9 && PHON(9)) {
            pg8::Gemm g{Z, (const bf16_t*)((const char*)Wb + W_DN), T, D, DFF, DFF}; pg8::StaticOrder S; S.init(T, D, c.G, c.bid);
            pg8::EpiRes<false> E{nullptr, KOUT, D, (bf16_t*)(ws + WS_SST), nullptr, l + 1 < DEPTH ? (bf16_t*)KOUT : nullptr};
            pg8::gemm_phase<pg8::EpiRes<false>>(ldsl, g, S, E, c.tid);
        }
    }
}

extern "C" void kernel_launch(void* const* d_in, const int* in_sizes, int n_in, void* d_out, int out_size, void* d_ws, size_t ws_size, hipStream_t stream) {
    static int grid = 0;
    if (grid == 0) {
        if (n_in != 14 || out_size != T * D || ws_size < WS_END) { fprintf(stderr, "kernel_launch: unexpected shapes (n_in %d out %d ws %zu)\n", n_in, out_size, ws_size); grid = -1; return; }
        int dev = 0, cus = 0, per_cu = 0;
        hipGetDevice(&dev); hipDeviceGetAttribute(&cus, hipDeviceAttributeMultiprocessorCount, dev);
        if (hipFuncSetAttribute((const void*)fwd_megakernel, hipFuncAttributeMaxDynamicSharedMemorySize, LDS_BYTES) != hipSuccess) { fprintf(stderr, "kernel_launch: hipFuncSetAttribute failed\n"); grid = -1; return; }
        if (hipOccupancyMaxActiveBlocksPerMultiprocessor(&per_cu, (const void*)fwd_megakernel, 512, LDS_BYTES) != hipSuccess || per_cu < 1) { fprintf(stderr, "kernel_launch: occupancy query says %d\n", per_cu); per_cu = 1; }
        (void)hipGetLastError();
        grid = cus * 1;
    }
    if (grid < 0) return;
    Args a{};
    for (int i = 0; i < 14; ++i) a.in[i] = (const float*)d_in[i];
    a.out = (float*)d_out; a.ws = (unsigned char*)d_ws;
#if MK_ONE_LAUNCH
    a.ph_lo = 0; a.ph_hi = NPH;
    void* args[] = {&a};
    hipError_t e = hipLaunchCooperativeKernel((const void*)fwd_megakernel, dim3(grid), dim3(512), args, LDS_BYTES, stream);
    if (e != hipSuccess) fprintf(stderr, "cooperative launch failed: %s (grid %d)\n", hipGetErrorString(e), grid);
#else
    for (int ph = 0; ph < NPH; ++ph) {
        a.ph_lo = ph; a.ph_hi = ph + 1;
        hipLaunchKernelGGL(fwd_megakernel, dim3(grid), dim3(512), LDS_BYTES, stream, a);
    }
#endif
}
```
